# Optimizing an MI355X kernel written in HIP

```python
import math
import jax, jax.numpy as jnp
from jax import lax
import numpy as np

D_MODEL = 1024
BATCH = 2
SEQ = 8192
DEPTH = 1

EPS = 1e-6
PLE_DIM = 256
ATTN_HEADS = 16
HEAD_DIM = 64
ATTN_WIDTH = ATTN_HEADS * HEAD_DIM
MOBA_BLOCK = 256
MOBA_TOPK = 3
Q_CHUNK = 32
SSM_INNER = 2 * D_MODEL
SSM_HEADDIM = 64
SSM_HEADS = SSM_INNER // SSM_HEADDIM
SSM_GROUPS = 4
SSM_STATE = 128
SSM_CONV = 4
SSM_CHUNK = 128
CONV_DIM = SSM_INNER + 2 * SSM_GROUPS * SSM_STATE
DT_MIN = 0.001
DT_MAX = 0.1
D_FF = -(-8 * D_MODEL // (3 * 256)) * 256
IN_SPLITS = (ATTN_WIDTH, ATTN_WIDTH, ATTN_WIDTH, SSM_INNER, CONV_DIM, SSM_HEADS, D_MODEL, D_MODEL)
IN_DIM = sum(IN_SPLITS)
IN_OFFSETS = tuple(np.cumsum(IN_SPLITS)[:-1].tolist())

kernel_name = "hybrid_moba_mamba2_gated_block"


def rms_norm(x, g):
    xf = x.astype(jnp.float32)
    y = xf * lax.rsqrt(jnp.mean(xf * xf, axis=-1, keepdims=True) + EPS)
    return (y * g.astype(jnp.float32)).astype(x.dtype)


def split_heads(t, b_, s):
    return t.reshape(b_, s, ATTN_HEADS, HEAD_DIM).transpose(0, 2, 1, 3)


def moba_attention(q, k, v):
    b_, nh, s, dh = q.shape
    nb = -(-s // MOBA_BLOCK)
    pad = nb * MOBA_BLOCK - s
    kp = jnp.pad(k, ((0, 0), (0, 0), (0, pad), (0, 0)))
    vp = jnp.pad(v, ((0, 0), (0, 0), (0, pad), (0, 0)))
    kb = kp.reshape(b_, nh, nb, MOBA_BLOCK, dh)
    vb = vp.reshape(b_, nh, nb, MOBA_BLOCK, dh)
    k_mean = jnp.mean(kb.astype(jnp.float32), axis=3)
    topk = min(MOBA_TOPK, nb)
    scale = dh ** -0.5
    bidx = jnp.arange(b_)[:, None, None, None]
    hidx = jnp.arange(nh)[None, :, None, None]
    blk_ids = jnp.arange(nb)

    def chunk(ci):
        start = ci * Q_CHUNK
        qc = lax.dynamic_slice_in_dim(q, start, Q_CHUNK, axis=2)
        qpos = start + jnp.arange(Q_CHUNK)
        own = start // MOBA_BLOCK
        gate = jnp.einsum('bhqd,bhnd->bhqn', qc.astype(jnp.float32), k_mean)
        gate = jnp.where(blk_ids < own, gate, -jnp.inf)
        _, sel = lax.top_k(gate, topk)
        sel_ok = sel < own
        ks = kb[bidx, hidx, sel]
        vs = vb[bidx, hidx, sel]
        s_sel = jnp.einsum('bhqd,bhqtkd->bhqtk', qc, ks, preferred_element_type=jnp.float32) * scale
        s_sel = jnp.where(sel_ok[..., None], s_sel, -jnp.inf)
        ko = lax.dynamic_slice_in_dim(kp, own * MOBA_BLOCK, MOBA_BLOCK, axis=2)
        vo = lax.dynamic_slice_in_dim(vp, own * MOBA_BLOCK, MOBA_BLOCK, axis=2)
        s_own = jnp.einsum('bhqd,bhkd->bhqk', qc, ko, preferred_element_type=jnp.float32) * scale
        kpos = own * MOBA_BLOCK + jnp.arange(MOBA_BLOCK)
        s_own = jnp.where(kpos[None, :] <= qpos[:, None], s_own, -jnp.inf)
        scores = jnp.concatenate([s_sel.reshape(b_, nh, Q_CHUNK, topk * MOBA_BLOCK), s_own], axis=-1)
        probs = jax.nn.softmax(scores, axis=-1).astype(v.dtype)
        p_sel = probs[..., :topk * MOBA_BLOCK].reshape(b_, nh, Q_CHUNK, topk, MOBA_BLOCK)
        p_own = probs[..., topk * MOBA_BLOCK:]
        return (jnp.einsum('bhqtk,bhqtkd->bhqd', p_sel, vs)
                + jnp.einsum('bhqk,bhkd->bhqd', p_own, vo))

    out = lax.map(chunk, jnp.arange(s // Q_CHUNK))
    return out.transpose(1, 2, 0, 3, 4).reshape(b_, nh, s, dh)


def causal_depthwise_conv(u, w, b):
    ch = u.shape[-1]
    out = lax.conv_general_dilated(u, w[:, None, :].astype(u.dtype), (1,), [(SSM_CONV - 1, 0)],
                                   dimension_numbers=('NWC', 'WIO', 'NWC'), feature_group_count=ch)
    return out + b.astype(u.dtype)


def segsum(a):
    t = a.shape[-1]
    xr = jnp.broadcast_to(a[..., :, None], a.shape + (t,))
    xr = jnp.where(jnp.tril(jnp.ones((t, t), bool), -1), xr, 0.0)
    cs = jnp.cumsum(xr, axis=-2)
    return jnp.where(jnp.tril(jnp.ones((t, t), bool)), cs, -jnp.inf)


def ssd_chunked(xh, dt, a_head, bm, cm):
    b_, s, h, p = xh.shape
    g, n = bm.shape[-2], bm.shape[-1]
    j = h // g
    L = SSM_CHUNK
    c = s // L
    xdt = (xh * dt[..., None]).reshape(b_, c, L, g, j, p)
    a = (dt * a_head).reshape(b_, c, L, h).transpose(0, 3, 1, 2)
    a_cs = jnp.cumsum(a, axis=-1)
    bc = bm.reshape(b_, c, L, g, n)
    cc = cm.reshape(b_, c, L, g, n)
    decay_in = jnp.exp(segsum(a)).reshape(b_, g, j, c, L, L)
    cb = jnp.einsum('bclgn,bcsgn->bgcls', cc, bc)
    y_diag = jnp.einsum('bgjcls,bcsgjp->bclgjp', cb[:, :, None] * decay_in, xdt)
    w_end = jnp.exp(a_cs[..., -1:] - a_cs).transpose(0, 2, 3, 1).reshape(b_, c, L, g, j)
    chunk_states = jnp.einsum('bclgn,bclgjp->bcgjpn', bc, xdt * w_end[..., None])
    chunk_decay = jnp.exp(a_cs[..., -1]).reshape(b_, g, j, c).transpose(3, 0, 1, 2)

    def step(state, inp):
        dec, new = inp
        return state * dec[..., None, None] + new, state

    init = jnp.zeros((b_, g, j, p, n), jnp.float32)
    _, prev = lax.scan(step, init, (chunk_decay, chunk_states.transpose(1, 0, 2, 3, 4, 5)))
    prev = prev.transpose(1, 0, 2, 3, 4, 5)
    w_start = jnp.exp(a_cs).transpose(0, 2, 3, 1).reshape(b_, c, L, g, j)
    y_off = jnp.einsum('bclgn,bcgjpn->bclgjp', cc, prev) * w_start[..., None]
    return (y_diag + y_off).reshape(b_, s, h, p)


def mamba2_mixer(z, xbc, dt_raw, conv_w, conv_b, dt_bias, a_log, d_skip, norm_g):
    b_, s, _ = z.shape
    f32 = jnp.float32
    xbc = jax.nn.silu(causal_depthwise_conv(xbc, conv_w, conv_b))
    xs, bm, cm = jnp.split(xbc, [SSM_INNER, SSM_INNER + SSM_GROUPS * SSM_STATE], axis=-1)
    dt = jax.nn.softplus(dt_raw.astype(f32) + dt_bias.astype(f32))
    a_head = -jnp.exp(a_log.astype(f32))
    xh = xs.astype(f32).reshape(b_, s, SSM_HEADS, SSM_HEADDIM)
    y = ssd_chunked(xh, dt, a_head,
                    bm.astype(f32).reshape(b_, s, SSM_GROUPS, SSM_STATE),
                    cm.astype(f32).reshape(b_, s, SSM_GROUPS, SSM_STATE))
    y = y + d_skip.astype(f32)[:, None] * xh
    y = y.reshape(b_, s, SSM_INNER) * jax.nn.silu(z.astype(f32))
    y = y.reshape(b_, s, SSM_GROUPS, SSM_INNER // SSM_GROUPS)
    y = y * lax.rsqrt(jnp.mean(y * y, axis=-1, keepdims=True) + EPS)
    return (y.reshape(b_, s, SSM_INNER) * norm_g.astype(f32)).astype(z.dtype)


def setup_inputs(seed: int = 0) -> dict:
    key = jax.random.key(seed)
    ks = jax.random.split(key, 24)
    f32 = jnp.float32

    def normal(k, shape, scale):
        return jax.random.normal(k, shape, f32) * scale

    def gain(k, shape):
        return 1.0 + 0.02 * jax.random.normal(k, shape, f32)

    dt0 = jnp.exp(jax.random.uniform(ks[9], (DEPTH, SSM_HEADS), f32, math.log(DT_MIN), math.log(DT_MAX)))
    return {
        "x": normal(ks[0], (BATCH, SEQ, D_MODEL), 1.0),
        "p": normal(ks[1], (DEPTH, BATCH, SEQ, PLE_DIM), 1.0),
        "ln1_g": gain(ks[2], (DEPTH, D_MODEL)),
        "w_in": normal(ks[3], (DEPTH, D_MODEL, IN_DIM), D_MODEL ** -0.5),
        "q_norm_g": gain(ks[4], (DEPTH, HEAD_DIM)),
        "k_norm_g": gain(ks[5], (DEPTH, HEAD_DIM)),
        "w_o_attn": normal(ks[6], (DEPTH, ATTN_WIDTH, D_MODEL), ATTN_WIDTH ** -0.5),
        "conv_w": normal(ks[7], (DEPTH, SSM_CONV, CONV_DIM), SSM_CONV ** -0.5),
        "conv_b": normal(ks[8], (DEPTH, CONV_DIM), 0.02),
        "dt_bias": dt0 + jnp.log(-jnp.expm1(-dt0)),
        "a_log": jnp.log(jax.random.uniform(ks[10], (DEPTH, SSM_HEADS), f32, 1.0, 16.0)),
        "d_skip": gain(ks[11], (DEPTH, SSM_HEADS)),
        "ssm_norm_g": gain(ks[12], (DEPTH, SSM_INNER)),
        "w_o_ssm": normal(ks[13], (DEPTH, SSM_INNER, D_MODEL), SSM_INNER ** -0.5),
        "w_out": normal(ks[14], (DEPTH, D_MODEL, D_MODEL), D_MODEL ** -0.5),
        "ln2_g": gain(ks[15], (DEPTH, D_MODEL)),
        "w_gate_up": normal(ks[16], (DEPTH, D_MODEL, 2 * D_FF), D_MODEL ** -0.5),
        "w_down": normal(ks[17], (DEPTH, D_FF, D_MODEL), D_FF ** -0.5),
        "ln3_g": gain(ks[18], (DEPTH, D_MODEL)),
        "w_ple_gate": normal(ks[19], (DEPTH, D_MODEL, D_MODEL), D_MODEL ** -0.5),
        "w_ple_proj": normal(ks[20], (DEPTH, PLE_DIM, D_MODEL), PLE_DIM ** -0.5),
    }


def reference(x, p, ln1_g, w_in, q_norm_g, k_norm_g, w_o_attn, conv_w, conv_b, dt_bias, a_log,
              d_skip, ssm_norm_g, w_o_ssm, w_out, ln2_g, w_gate_up, w_down, ln3_g, w_ple_gate,
              w_ple_proj):
    b_, s, _ = x.shape
    for i in range(DEPTH):
        h = rms_norm(x, ln1_g[i])
        proj = h @ w_in[i]
        q, k, v, z, xbc, dt_raw, gate_a, gate_b = jnp.split(proj, IN_OFFSETS, axis=-1)
        qh = rms_norm(split_heads(q, b_, s), q_norm_g[i])
        kh = rms_norm(split_heads(k, b_, s), k_norm_g[i])
        vh = split_heads(v, b_, s)
        att = moba_attention(qh, kh, vh)
        y_a = att.transpose(0, 2, 1, 3).reshape(b_, s, ATTN_WIDTH) @ w_o_attn[i]
        y_b = mamba2_mixer(z, xbc, dt_raw, conv_w[i], conv_b[i], dt_bias[i], a_log[i],
                           d_skip[i], ssm_norm_g[i]) @ w_o_ssm[i]
        merged = jax.nn.sigmoid(gate_a) * y_a + jax.nn.sigmoid(gate_b) * y_b
        x = x + merged @ w_out[i]
        h2 = rms_norm(x, ln2_g[i])
        g_ff, u_ff = jnp.split(h2 @ w_gate_up[i], 2, axis=-1)
        x = x + (jax.nn.silu(g_ff) * u_ff) @ w_down[i]
        h3 = rms_norm(x, ln3_g[i])
        x = x + (p[i] @ w_ple_proj[i]) * jax.nn.sigmoid(h3 @ w_ple_gate[i])
    return x
```

```cpp
#include <hip/hip_runtime.h>
#include <hip/hip_cooperative_groups.h>
#include <cstdio>
#include <cstdint>
namespace cg = cooperative_groups;
namespace pg8 {
#define PG8_LAS __attribute__((address_space(3)))
typedef unsigned short bf16_t;
typedef short bf16x8 __attribute__((ext_vector_type(8)));
typedef float f32x4 __attribute__((ext_vector_type(4)));
typedef unsigned u32x4 __attribute__((ext_vector_type(4)));
constexpr int BM = 256, BK = 64, HALF = 128, HTB = HALF * BK * 2  , STAGE_BYTES = 8 * HTB, NXCD = 8, WGM = 4;

__host__ __device__ __forceinline__ int lds_byte(int r, int c) { const int st = (r >> 4) * 2 + (c >> 5), rr = r & 15, cc = c & 31, ob = rr * 64 + cc * 2; return st * 1024 + (ob ^ (((ob >> 9) & 1) << 5)); }
__host__ __device__ __forceinline__ void stage_rc(int b, int& R, int& C) { const int st = b / 1024, sb = b % 1024, swz = sb ^ (((sb >> 9) & 1) << 5); R = (st >> 1) * 16 + swz / 64; C = (st & 1) * 32 + (swz % 64) / 2; }
__host__ __device__ __forceinline__ int perm32(int rho) { const int n = rho >> 4, i = rho & 15; return 8 * (i >> 2) + 4 * n + (i & 3); }

struct Unit { int pm, pn; };
struct Gemm { const bf16_t* A; const bf16_t* Bt; int M, N, K; };

struct StaticOrder {
    int nM, nN, nwg, G, c;
    __host__ __device__ void init(int M, int N, int G_, int c_) { nM = M / BM; nN = N / BM; nwg = nM * nN; G = G_; c = c_; }
    __host__ __device__ bool next(int i, Unit& u) const {
        const long L = (long)i * G + c; if (L >= nwg) return false;
        int wgid = (int)L; { const int q = nwg / NXCD, r = nwg % NXCD, xcd = wgid % NXCD, off = wgid / NXCD; wgid = (xcd < r ? xcd * (q + 1) : r * (q + 1) + (xcd - r) * q) + off; }
        const int nig = WGM * nN, gid = wgid / nig, fm = gid * WGM, gsz = (nM - fm) < WGM ? (nM - fm) : WGM;
        u.pm = fm + ((wgid % nig) % gsz); u.pn = (wgid % nig) / gsz; return true;
    }
    __device__ __forceinline__ void a_ready(const Unit&) const {}
    __device__ __forceinline__ void done(const Unit&) const {}
};

__device__ __forceinline__ unsigned cvt_pk_bf16(float lo, float hi) { unsigned r; asm volatile("v_cvt_pk_bf16_f32 %0, %1, %2" : "=v"(r) : "v"(lo), "v"(hi)); return r; }
typedef float f32x2 __attribute__((ext_vector_type(2)));
__device__ __forceinline__ int fresh_lane() { int l; asm volatile("v_mbcnt_lo_u32_b32 %0, -1, 0\n\tv_mbcnt_hi_u32_b32 %0, -1, %0" : "=v"(l)); return l; }
template <class Epi, class Sched, bool ALIGN_EPI = false, bool SP2 = false>
__device__ __forceinline__ void gemm_phase(PG8_LAS unsigned char* lds, const Gemm g, const Sched& S, const Epi& E, int wave_s) {
    const int lane = fresh_lane(), tid = wave_s * 64 + lane, wid = wave_s, wr = wid >> 2, wc = wid & 3, fr = lane & 15, fq = lane >> 4;
    const int K = g.K, nt = K / BK;
    unsigned voffA[2], voffB[2];
#pragma unroll
    for (int i = 0; i < 2; ++i) { int R, C; stage_rc(tid * 16 + i * 8192, R, C); const int Rb = Epi::PERM ? ((R & ~31) + perm32(R & 31)) : R;
        voffA[i] = (unsigned)(R * K + C) * 2u; voffB[i] = (unsigned)(Rb * K + C) * 2u; }
    const size_t kstep = (size_t)(BK * 2);
    const size_t hstep = (size_t)HALF * K * 2;
    const size_t tstep = 2 * hstep;
    const unsigned ldsw = (unsigned)wid * 1024u;
    const int aoff = lds_byte(wr * 64 + fr, fq * 8), boff = lds_byte(wc * 32 + fr, fq * 8);
#define PG8_SA(b, h) (((b) * 2 + (h)) * HTB)
#define PG8_SB(b, h) ((4 + (b) * 2 + (h)) * HTB)
#define PG8_STAGE(bufoff, gbase, voff) do { _Pragma("unroll") for (int _i = 0; _i < 2; ++_i) \
        __builtin_amdgcn_global_load_lds((const unsigned*)((const char*)(gbase) + (voff)[_i]), (PG8_LAS unsigned*)(lds + (bufoff) + ldsw + _i * 8192), 16, 0, 0); } while (0)
#define PG8_LDA(dst, b, h) do { _Pragma("unroll") for (int m = 0; m < 4; ++m) _Pragma("unroll") for (int k = 0; k < 2; ++k) dst[m][k] = *(const PG8_LAS bf16x8*)(lds + PG8_SA(b, h) + aoff + m * 2048 + k * 1024); } while (0)
#define PG8_LDB(dst, b, h) do { _Pragma("unroll") for (int n = 0; n < 2; ++n) _Pragma("unroll") for (int k = 0; k < 2; ++k) dst[n][k] = *(const PG8_LAS bf16x8*)(lds + PG8_SB(b, h) + boff + n * 2048 + k * 1024); } while (0)
#define PG8_MMA(ai, bj, At, Bt) do { __builtin_amdgcn_s_setprio(1); _Pragma("unroll") for (int m = 0; m < 4; ++m) _Pragma("unroll") for (int n = 0; n < 2; ++n) _Pragma("unroll") for (int k = 0; k < 2; ++k) \
        acc[ai][bj][m][n] = __builtin_amdgcn_mfma_f32_16x16x32_bf16(Bt[n][k], At[m][k], acc[ai][bj][m][n], 0, 0, 0); __builtin_amdgcn_s_setprio(0); } while (0)
#define PG8_WAIT_V(n) asm volatile("s_waitcnt vmcnt(" #n ")" ::: "memory")
#define PG8_WAIT_L(n) asm volatile("s_waitcnt lgkmcnt(" #n ")" ::: "memory")
#define PG8_BAR __builtin_amdgcn_s_barrier()
#define PG8_SCHED __builtin_amdgcn_sched_barrier(0)
    Unit cur, nxt; int ui = 0;
    if (!S.next(0, cur)) return;
    f32x4 acc[2][2][4][2];
#pragma unroll
    for (int a = 0; a < 2; ++a)
#pragma unroll
        for (int b = 0; b < 2; ++b)
#pragma unroll
            for (int m = 0; m < 4; ++m)
#pragma unroll
                for (int n = 0; n < 2; ++n) acc[a][b][m][n] = (f32x4){0.f, 0.f, 0.f, 0.f};
    bf16x8 At[4][2], B0[2][2], B1[2][2];
    const char* cA = (const char*)g.A + (size_t)cur.pm * tstep; const char* cB = (const char*)g.Bt + (size_t)cur.pn * tstep;
    S.a_ready(cur);
    if constexpr (SP2) {
        PG8_STAGE(PG8_SB(0, 0), cB, voffB); PG8_STAGE(PG8_SB(0, 1), cB + hstep, voffB); PG8_STAGE(PG8_SA(0, 0), cA, voffA); PG8_STAGE(PG8_SA(0, 1), cA + hstep, voffA);
        if (wr == 1) PG8_BAR;
        PG8_WAIT_V(2); PG8_BAR;
        PG8_STAGE(PG8_SB(1, 0), cB + kstep, voffB); PG8_STAGE(PG8_SA(1, 0), cA + kstep, voffA); PG8_STAGE(PG8_SB(1, 1), cB + hstep + kstep, voffB);
        PG8_WAIT_V(6); PG8_BAR;
    } else {
        PG8_STAGE(PG8_SB(0, 0), cB, voffB); PG8_STAGE(PG8_SA(0, 0), cA, voffA); PG8_STAGE(PG8_SB(0, 1), cB + hstep, voffB); PG8_STAGE(PG8_SA(0, 1), cA + hstep, voffA);
        if (wr == 1) PG8_BAR;
        PG8_WAIT_V(4); PG8_BAR;
        PG8_STAGE(PG8_SB(1, 0), cB + kstep, voffB); PG8_STAGE(PG8_SA(1, 0), cA + kstep, voffA); PG8_STAGE(PG8_SB(1, 1), cB + hstep + kstep, voffB);
        PG8_WAIT_V(6); PG8_BAR;
    }
    for (;;) {
        const bool has_next = S.next(ui + 1, nxt);
        const char* nA = has_next ? (const char*)g.A + (size_t)nxt.pm * tstep : cA; const char* nB = has_next ? (const char*)g.Bt + (size_t)nxt.pn * tstep : cB;
        for (int t = 0; t < nt; t += 2) {
            const bool last = (t == nt - 2);
            const char* a1 = cA + (size_t)(t + 1) * kstep;
            const char* a2 = last ? nA : cA + (size_t)(t + 2) * kstep; const char* b2 = last ? nB : cB + (size_t)(t + 2) * kstep;
            const char* a3 = a2 + kstep; const char* b3 = b2 + kstep;
            if (last && has_next) S.a_ready(nxt);
            if constexpr (SP2) {
            PG8_LDB(B0, 0, 0); PG8_LDB(B1, 0, 1); PG8_SCHED; PG8_LDA(At, 0, 0); PG8_STAGE(PG8_SA(1, 1), a1 + hstep, voffA);
            PG8_WAIT_V(8); PG8_WAIT_L(0); PG8_BAR; PG8_MMA(0, 0, At, B0); PG8_MMA(0, 1, At, B1); PG8_BAR; PG8_SCHED;
            PG8_LDA(At, 0, 1); PG8_STAGE(PG8_SB(0, 0), b2, voffB); PG8_STAGE(PG8_SB(0, 1), b2 + hstep, voffB); PG8_STAGE(PG8_SA(0, 0), a2, voffA);
            PG8_WAIT_V(8); PG8_WAIT_L(0); PG8_BAR; PG8_MMA(1, 0, At, B0); PG8_MMA(1, 1, At, B1); PG8_BAR; PG8_SCHED;
            PG8_LDB(B0, 1, 0); PG8_LDB(B1, 1, 1); PG8_SCHED; PG8_LDA(At, 1, 0); PG8_STAGE(PG8_SA(0, 1), a2 + hstep, voffA);
            PG8_WAIT_V(8); PG8_WAIT_L(0); PG8_BAR; PG8_MMA(0, 0, At, B0); PG8_MMA(0, 1, At, B1); PG8_BAR; PG8_SCHED;
            PG8_LDA(At, 1, 1); PG8_STAGE(PG8_SB(1, 0), b3, voffB); PG8_STAGE(PG8_SB(1, 1), b3 + hstep, voffB); PG8_STAGE(PG8_SA(1, 0), a3, voffA);
            PG8_WAIT_V(8); PG8_WAIT_L(0); PG8_BAR; PG8_MMA(1, 0, At, B0); PG8_MMA(1, 1, At, B1); PG8_BAR; PG8_SCHED;
            } else {
            PG8_LDB(B0, 0, 0); PG8_SCHED; PG8_LDA(At, 0, 0); PG8_STAGE(PG8_SA(1, 1), a1 + hstep, voffA);
            PG8_WAIT_L(8); PG8_BAR; PG8_WAIT_L(0); PG8_MMA(0, 0, At, B0); PG8_BAR; PG8_SCHED;
            PG8_LDB(B1, 0, 1); PG8_STAGE(PG8_SB(0, 0), b2, voffB);
            PG8_BAR; PG8_WAIT_L(0); PG8_MMA(0, 1, At, B1); PG8_BAR;
            PG8_LDA(At, 0, 1); PG8_STAGE(PG8_SA(0, 0), a2, voffA);
            PG8_BAR; PG8_WAIT_L(0); PG8_MMA(1, 0, At, B0); PG8_BAR; PG8_SCHED;
            PG8_STAGE(PG8_SB(0, 1), b2 + hstep, voffB);
            PG8_WAIT_V(6); PG8_BAR; PG8_MMA(1, 1, At, B1); PG8_BAR;
            PG8_LDB(B0, 1, 0); PG8_SCHED; PG8_LDA(At, 1, 0); PG8_STAGE(PG8_SA(0, 1), a2 + hstep, voffA);
            PG8_WAIT_L(8); PG8_BAR; PG8_WAIT_L(0); PG8_MMA(0, 0, At, B0); PG8_BAR; PG8_SCHED;
            PG8_LDB(B1, 1, 1); PG8_STAGE(PG8_SB(1, 0), b3, voffB);
            PG8_BAR; PG8_WAIT_L(0); PG8_MMA(0, 1, At, B1); PG8_BAR;
            PG8_LDA(At, 1, 1); PG8_STAGE(PG8_SA(1, 0), a3, voffA);
            PG8_BAR; PG8_WAIT_L(0); PG8_MMA(1, 0, At, B0); PG8_BAR; PG8_SCHED;
            PG8_STAGE(PG8_SB(1, 1), b3 + hstep, voffB);
            PG8_WAIT_V(6); PG8_BAR; PG8_MMA(1, 1, At, B1); PG8_BAR;
            }
        }
        if constexpr (ALIGN_EPI) { if (wr == 0) PG8_BAR; }
        if constexpr (!Epi::AFTER_DRAIN) { E(acc, cur, wr, wc, fr, fq); S.done(cur); }
        if (!has_next) break;
#pragma unroll
        for (int a = 0; a < 2; ++a)
#pragma unroll
            for (int b = 0; b < 2; ++b)
#pragma unroll
                for (int m = 0; m < 4; ++m)
#pragma unroll
                    for (int n = 0; n < 2; ++n) acc[a][b][m][n] = (f32x4){0.f, 0.f, 0.f, 0.f};
        cur = nxt; cA = nA; cB = nB; ++ui;
        if constexpr (ALIGN_EPI) { if (wr == 1) PG8_BAR; }
    }
    PG8_WAIT_V(0);
    if constexpr (!ALIGN_EPI) { if (wr == 0) PG8_BAR; }
    PG8_BAR;
    if constexpr (Epi::AFTER_DRAIN) { E.fused(acc, cur, wr, wc, fr, fq, lds, wid, lane); S.done(cur); }
#undef PG8_SA
#undef PG8_SB
#undef PG8_STAGE
#undef PG8_LDA
#undef PG8_LDB
#undef PG8_MMA
#undef PG8_WAIT_V
#undef PG8_WAIT_L
#undef PG8_BAR
#undef PG8_SCHED
}
}

constexpr int BATCH = 2, SEQ = 8192, DM = 1024, M = BATCH * SEQ;
constexpr int NH = 16, HD = 64, BLK = 256, NBLK = SEQ / BLK;
constexpr int SSM_IN = 2048, SSM_H = 32, SSM_P = 64, SSM_G = 4, SSM_N = 128, CONVD = 3072;
constexpr int DFF = 2816, PLE = 256, IN_DIM = 10272;
constexpr float EPS = 1e-6f;
constexpr int NWAVES = 8, NTHR = 512;

#define GAS __attribute__((address_space(1)))
#define LAS __attribute__((address_space(3)))
typedef unsigned short bf16;
typedef unsigned v4u __attribute__((ext_vector_type(4)));
typedef float f32x4 __attribute__((ext_vector_type(4)));
typedef short bf16x8 __attribute__((ext_vector_type(8)));
#define LDS_WAIT() asm volatile("s_waitcnt lgkmcnt(0)" ::: "memory")

__device__ __forceinline__ float bf2f(unsigned short b) { return __uint_as_float(((unsigned)b) << 16); }
__device__ __forceinline__ unsigned f2bf(float f) { unsigned u = __float_as_uint(f); return (u + 0x7fffu + ((u >> 16) & 1u)) >> 16; }
typedef __bf16 bf16x2_t __attribute__((ext_vector_type(2))); typedef float f32x2_t __attribute__((ext_vector_type(2)));
__device__ __forceinline__ unsigned pk2(float lo, float hi) { f32x2_t v = {lo, hi}; bf16x2_t b = __builtin_convertvector(v, bf16x2_t); return __builtin_bit_cast(unsigned, b); }
__device__ __forceinline__ float wave_sum(float v) {
#pragma unroll
    for (int o = 1; o < 64; o <<= 1) v += __shfl_xor(v, o);
    return v;
}
__device__ __forceinline__ float sigm(float x) { return __builtin_amdgcn_rcpf(1.f + __builtin_amdgcn_exp2f(x * -1.4426950408889634f)); }
__device__ __forceinline__ float siluf(float x) { return x * sigm(x); }

constexpr size_t MiB = 1u << 20;
constexpr size_t WS_R1 = 0, WS_KMEAN = 254 * MiB  , WS_R2P = 1 * MiB, WS_R3P = 2 * MiB, WS_DT = 3 * MiB;
constexpr size_t WS_BAR = 640 * 1024, BAR_BYTES = 32768;
constexpr size_t WS_WIN = 5 * MiB;
constexpr size_t WS_WOA = 26 * MiB, WS_WOS = 28 * MiB;
constexpr size_t WS_Q = 32 * MiB, WS_K = 64 * MiB, WS_V = 96 * MiB;
constexpr size_t WS_Z = 64 * MiB;
constexpr size_t WS_XBC = 128 * MiB;
constexpr size_t WS_WOUT = 224 * MiB, WS_WGU = 226 * MiB, WS_WDN = 237 * MiB, WS_WPG = 243 * MiB, WS_WPP = 245 * MiB, WS_PB = 246 * MiB;
constexpr size_t WS_GA = 128 * MiB, WS_GB = 160 * MiB;
constexpr size_t WS_X1B = 192 * MiB;
constexpr size_t WS_ACT = 32 * MiB, WS_X2B = 160 * MiB, WS_PP = 128 * MiB;
constexpr size_t WS_TAIL = 254 * MiB + 512 * 1024;
constexpr size_t WS_END = 256 * MiB;
constexpr size_t OUT_XB = 0;

namespace ep {
using pg8::bf16_t; using pg8::Unit; using pg8::u32x4; using pg8::cvt_pk_bf16;
__device__ __forceinline__ u32x4 pack8(f32x4 a, f32x4 b) { u32x4 w; w.x = pk2(a[0], a[1]); w.y = pk2(a[2], a[3]); w.z = pk2(b[0], b[1]); w.w = pk2(b[2], b[3]); return w; }
__device__ __forceinline__ uint2 pack8_fp8(f32x4 a, f32x4 b) { int w0 = 0, w1 = 0;
    w0 = __builtin_amdgcn_cvt_pk_fp8_f32(a[0], a[1], w0, false); w0 = __builtin_amdgcn_cvt_pk_fp8_f32(a[2], a[3], w0, true);
    w1 = __builtin_amdgcn_cvt_pk_fp8_f32(b[0], b[1], w1, false); w1 = __builtin_amdgcn_cvt_pk_fp8_f32(b[2], b[3], w1, true); return make_uint2((unsigned)w0, (unsigned)w1); }
__device__ __forceinline__ void unpack8(u32x4 w, f32x4& a, f32x4& b) {
    a[0] = __uint_as_float(w.x << 16); a[1] = __uint_as_float(w.x & 0xffff0000u); a[2] = __uint_as_float(w.y << 16); a[3] = __uint_as_float(w.y & 0xffff0000u);
    b[0] = __uint_as_float(w.z << 16); b[1] = __uint_as_float(w.z & 0xffff0000u); b[2] = __uint_as_float(w.w << 16); b[3] = __uint_as_float(w.w & 0xffff0000u); }
__device__ __forceinline__ float dot4(f32x4 v) { return (v[0] * v[0] + v[1] * v[1]) + (v[2] * v[2] + v[3] * v[3]); }

template <int ACT> struct EpiAct {
    static constexpr bool PERM = true, AFTER_DRAIN = false;
    bf16_t* O; int ldc; const float* rs; int split_tiles; size_t split_stride;
    __device__ __forceinline__ void operator()(const f32x4 (&acc)[2][2][4][2], const Unit& u, int wr, int wc, int fr, int fq) const {
        int pn = u.pn; bf16_t* base = O; if (split_tiles) { const int t = pn / split_tiles; base += (size_t)t * split_stride; pn -= t * split_tiles; }
        const int row0 = u.pm * 256 + wr * 64 + fr, col0 = pn * 256 + wc * 32 + 8 * fq;
        float sv[8];
#pragma unroll
        for (int i = 0; i < 8; ++i) sv[i] = rs ? rs[row0 + (i >> 2) * 128 + (i & 3) * 16] : 1.f;
        asm volatile("" ::: "memory");
#pragma unroll
        for (int ai = 0; ai < 2; ++ai)
#pragma unroll
            for (int m = 0; m < 4; ++m) { const int row = row0 + ai * 128 + m * 16; const float s = sv[ai * 4 + m]; bf16_t* rowp = base + (size_t)row * ldc + col0;
#pragma unroll
                for (int bj = 0; bj < 2; ++bj) { f32x4 v0 = acc[ai][bj][m][0] * s, v1 = acc[ai][bj][m][1] * s;
                    if (ACT == 1) { v0 = (f32x4){siluf(v0[0]), siluf(v0[1]), siluf(v0[2]), siluf(v0[3])}; v1 = (f32x4){siluf(v1[0]), siluf(v1[1]), siluf(v1[2]), siluf(v1[3])}; }
                    if (ACT == 2) { v0 = (f32x4){sigm(v0[0]), sigm(v0[1]), sigm(v0[2]), sigm(v0[3])}; v1 = (f32x4){sigm(v1[0]), sigm(v1[1]), sigm(v1[2]), sigm(v1[3])}; }
                    *(u32x4*)(rowp + bj * 128) = pack8(v0, v1); } }
    }
};
struct EpiQKV {
    static constexpr bool PERM = true, AFTER_DRAIN = false;
    bf16_t *Q, *K, *V; const float* r1; const float* gq; const float* gk; float* KS;
    __device__ __forceinline__ void operator()(const f32x4 (&acc)[2][2][4][2], const Unit& u, int wr, int wc, int fr, int fq) const {
        const int sect = u.pn >> 2, pt = u.pn & 3; const int row0 = u.pm * 256 + wr * 64 + fr;
        {
            const float* g = sect == 0 ? gq : gk; bf16_t* O = sect == 0 ? Q : K;
            const int head = pt * 4 + wc, col0 = head * 64 + 8 * fq;
            f32x4 cs[2][2];
#pragma unroll
            for (int bj = 0; bj < 2; ++bj) { cs[bj][0] = (f32x4){0.f, 0.f, 0.f, 0.f}; cs[bj][1] = (f32x4){0.f, 0.f, 0.f, 0.f}; }
            float sv[8]; f32x4 gv[2][2];
#pragma unroll
            for (int i = 0; i < 8; ++i) sv[i] = r1[row0 + (i >> 2) * 128 + (i & 3) * 16];
#pragma unroll
            for (int bj = 0; bj < 2; ++bj) { gv[bj][0] = *(const f32x4*)(g + 32 * bj + 8 * fq); gv[bj][1] = *(const f32x4*)(g + 32 * bj + 8 * fq + 4); }
            asm volatile("" ::: "memory");
            float ss8[8];
#pragma unroll
            for (int i = 0; i < 8; ++i) { float ss = 0.f;
#pragma unroll
                for (int bj = 0; bj < 2; ++bj)
#pragma unroll
                    for (int n = 0; n < 2; ++n) ss += dot4(acc[i >> 2][bj][i & 3][n]);
                ss8[i] = ss; }
#pragma unroll
            for (int i = 0; i < 8; ++i) ss8[i] += __shfl_xor(ss8[i], 16);
#pragma unroll
            for (int i = 0; i < 8; ++i) ss8[i] += __shfl_xor(ss8[i], 32);
#pragma unroll
            for (int ai = 0; ai < 2; ++ai)
#pragma unroll
                for (int m = 0; m < 4; ++m) { const int row = row0 + ai * 128 + m * 16; const float s = sv[ai * 4 + m];
                    const float ss = ss8[ai * 4 + m];
                    const float scl = s * rsqrtf(ss * s * s * (1.f / 64.f) + EPS);
                    bf16_t* rowq = O + (size_t)row * 1024 + col0;
                    unsigned char* rowk = (unsigned char*)O + (((((size_t)(u.pm >> 5) * NH + head) * NBLK + (u.pm & 31)) * 4 + 2 * (fq & 1)) * 256 + (size_t)(row & 255)) * 16 + 8 * (fq >> 1);
#pragma unroll
                    for (int bj = 0; bj < 2; ++bj) { const f32x4 g0 = gv[bj][0], g1 = gv[bj][1];
                        const f32x4 v0 = acc[ai][bj][m][0] * scl * g0, v1 = acc[ai][bj][m][1] * scl * g1;
                        cs[bj][0] += v0; cs[bj][1] += v1;
                        if (sect == 0) *(u32x4*)(rowq + bj * 32) = pack8(v0, v1); else *(uint2*)(rowk + bj * 4096) = pack8_fp8(v0, v1); }
                    asm volatile("" ::: "memory"); }
            if (sect == 1) {
#pragma unroll
                for (int o = 1; o < 16; o <<= 1)
#pragma unroll
                    for (int bj = 0; bj < 2; ++bj)
#pragma unroll
                        for (int n = 0; n < 2; ++n)
#pragma unroll
                            for (int j = 0; j < 4; ++j) cs[bj][n][j] += __shfl_xor(cs[bj][n][j], o);
                if (fr == 0) { float* kp = KS + ((((size_t)(u.pm >> 5) * NH + head) * NBLK + (u.pm & 31)) * 2 + wr) * 64 + 8 * fq;
#pragma unroll
                    for (int bj = 0; bj < 2; ++bj) { *(f32x4*)(kp + 32 * bj) = cs[bj][0]; *(f32x4*)(kp + 32 * bj + 4) = cs[bj][1]; } }
            }
        }
    }
};
struct EpiVt {
    static constexpr bool PERM = true, AFTER_DRAIN = false;
    bf16_t* O; const float* r1;
    __device__ __forceinline__ void operator()(const f32x4 (&acc)[2][2][4][2], const Unit& u, int wr, int wc, int fr, int fq) const {
        const int row0 = u.pm * 256 + wr * 64 + fr, col0 = u.pn * 256 + wc * 32 + 8 * fq;
        f32x4 s[2][2];
#pragma unroll
        for (int bj = 0; bj < 2; ++bj) { s[bj][0] = *(const f32x4*)(r1 + col0 + bj * 128); s[bj][1] = *(const f32x4*)(r1 + col0 + bj * 128 + 4); }
#pragma unroll
        for (int ai = 0; ai < 2; ++ai)
#pragma unroll
            for (int m = 0; m < 4; ++m) { const int row = row0 + ai * 128 + m * 16;
                bf16_t* rowp = O + (((((size_t)(u.pn >> 5) * NH + (row >> 6)) * NBLK + (u.pn & 31)) * 32 + 4 * wc + fq) * 64 + (row & 63)) * 8;
#pragma unroll
                for (int bj = 0; bj < 2; ++bj) *(u32x4*)(rowp + bj * 16 * 512) = pack8(acc[ai][bj][m][0] * s[bj][0], acc[ai][bj][m][1] * s[bj][1]); }
    }
};
struct EpiGate1 {
    static constexpr bool PERM = true, AFTER_DRAIN = false;
    bf16_t* G;
    __device__ __forceinline__ void operator()(const f32x4 (&acc)[2][2][4][2], const Unit& u, int wr, int wc, int fr, int fq) const {
        const int row0 = u.pm * 256 + wr * 64 + fr, col0 = u.pn * 256 + wc * 32 + 8 * fq;
        u32x4 gw[2][4][2];
#pragma unroll
        for (int ai = 0; ai < 2; ++ai)
#pragma unroll
            for (int m = 0; m < 4; ++m)
#pragma unroll
                for (int bj = 0; bj < 2; ++bj) gw[ai][m][bj] = *(const u32x4*)(G + (size_t)(row0 + ai * 128 + m * 16) * 1024 + col0 + bj * 128);
        asm volatile("" ::: "memory");
#pragma unroll
        for (int ai = 0; ai < 2; ++ai)
#pragma unroll
            for (int m = 0; m < 4; ++m) { bf16_t* rowp = G + (size_t)(row0 + ai * 128 + m * 16) * 1024 + col0;
#pragma unroll
                for (int bj = 0; bj < 2; ++bj) { f32x4 s0, s1; unpack8(gw[ai][m][bj], s0, s1);
                    *(u32x4*)(rowp + bj * 128) = pack8(acc[ai][bj][m][0] * s0, acc[ai][bj][m][1] * s1); } }
    }
};
struct EpiGate2 {
    static constexpr bool PERM = true, AFTER_DRAIN = false;
    bf16_t* G; const bf16_t* Gb;
    __device__ __forceinline__ void operator()(const f32x4 (&acc)[2][2][4][2], const Unit& u, int wr, int wc, int fr, int fq) const {
        const int row0 = u.pm * 256 + wr * 64 + fr, col0 = u.pn * 256 + wc * 32 + 8 * fq;
#pragma unroll
        for (int ai = 0; ai < 2; ++ai) {
            u32x4 gw[4][2], bw[4][2];
#pragma unroll
            for (int m = 0; m < 4; ++m)
#pragma unroll
                for (int bj = 0; bj < 2; ++bj) { const size_t off = (size_t)(row0 + ai * 128 + m * 16) * 1024 + col0 + bj * 128; gw[m][bj] = *(const u32x4*)(G + off); bw[m][bj] = *(const u32x4*)(Gb + off); }
#pragma unroll
            for (int m = 0; m < 4; ++m)
#pragma unroll
                for (int bj = 0; bj < 2; ++bj) { const size_t off = (size_t)(row0 + ai * 128 + m * 16) * 1024 + col0 + bj * 128;
                    f32x4 a0, a1, s0, s1; unpack8(gw[m][bj], a0, a1); unpack8(bw[m][bj], s0, s1);
                    *(u32x4*)(G + off) = pack8(a0 + acc[ai][bj][m][0] * s0, a1 + acc[ai][bj][m][1] * s1); }
        }
    }
};
template <bool BASE_BF16> struct EpiRes {
    static constexpr bool PERM = true, AFTER_DRAIN = false;
    const void* base; bf16_t* xb; float* part;
    __device__ __forceinline__ void operator()(const f32x4 (&acc)[2][2][4][2], const Unit& u, int wr, int wc, int fr, int fq) const {
        const int row0 = u.pm * 256 + wr * 64 + fr, col0 = u.pn * 256 + wc * 32 + 8 * fq;
#pragma unroll
        for (int ai = 0; ai < 2; ++ai) {
            f32x4 b0[4][2], b1[4][2];
#pragma unroll
            for (int m = 0; m < 4; ++m)
#pragma unroll
                for (int bj = 0; bj < 2; ++bj) { const size_t off = (size_t)(row0 + ai * 128 + m * 16) * 1024 + col0 + bj * 128;
                    if (BASE_BF16) unpack8(*(const u32x4*)((const bf16_t*)base + off), b0[m][bj], b1[m][bj]); else { b0[m][bj] = *(const f32x4*)((const float*)base + off); b1[m][bj] = *(const f32x4*)((const float*)base + off + 4); } }
            asm volatile("" ::: "memory");
            float ss4[4];
#pragma unroll
            for (int m = 0; m < 4; ++m) { const int row = row0 + ai * 128 + m * 16; float ss = 0.f;
#pragma unroll
                for (int bj = 0; bj < 2; ++bj) { const size_t off = (size_t)row * 1024 + col0 + bj * 128;
                    const f32x4 v0 = b0[m][bj] + acc[ai][bj][m][0], v1 = b1[m][bj] + acc[ai][bj][m][1];
                    *(u32x4*)(xb + off) = pack8(v0, v1); ss += dot4(v0) + dot4(v1); }
                ss4[m] = ss; }
#pragma unroll
            for (int m = 0; m < 4; ++m) ss4[m] += __shfl_xor(ss4[m], 16);
#pragma unroll
            for (int m = 0; m < 4; ++m) ss4[m] += __shfl_xor(ss4[m], 32);
#pragma unroll
            for (int m = 0; m < 4; ++m) if (fq == 0) part[(size_t)(row0 + ai * 128 + m * 16) * 16 + u.pn * 4 + wc] = ss4[m];
        }
    }
};
__device__ __forceinline__ float row_rs(const float* part, int row, int fq) {
    const f32x4 pv = *(const f32x4*)(part + (size_t)row * 16 + 4 * fq); float s = (pv[0] + pv[1]) + (pv[2] + pv[3]);
    s += __shfl_xor(s, 16); s += __shfl_xor(s, 32); return rsqrtf(s * (1.f / 1024.f) + EPS);
}
__device__ __forceinline__ void rows_rs8(const float* part, int row0, int fq, float (&r)[8]) {
    f32x4 pv[8];
#pragma unroll
    for (int i = 0; i < 8; ++i) pv[i] = *(const f32x4*)(part + (size_t)(row0 + (i >> 2) * 128 + (i & 3) * 16) * 16 + 4 * fq);
#pragma unroll
    for (int i = 0; i < 8; ++i) r[i] = (pv[i][0] + pv[i][1]) + (pv[i][2] + pv[i][3]);
#pragma unroll
    for (int i = 0; i < 8; ++i) r[i] += __shfl_xor(r[i], 16);
#pragma unroll
    for (int i = 0; i < 8; ++i) r[i] += __shfl_xor(r[i], 32);
#pragma unroll
    for (int i = 0; i < 8; ++i) r[i] = rsqrtf(r[i] * (1.f / 1024.f) + EPS);
}
struct EpiSwiGLU {
    static constexpr bool PERM = true, AFTER_DRAIN = false;
    bf16_t* O; const float* part;
    __device__ __forceinline__ void operator()(const f32x4 (&acc)[2][2][4][2], const Unit& u, int wr, int wc, int fr, int fq) const {
        const int row0 = u.pm * 256 + wr * 64 + fr, col0 = u.pn * 128 + wc * 32 + 8 * fq;
        float rr[8]; rows_rs8(part, row0, fq, rr);
#pragma unroll
        for (int ai = 0; ai < 2; ++ai)
#pragma unroll
            for (int m = 0; m < 4; ++m) { const int row = row0 + ai * 128 + m * 16; const float r = rr[ai * 4 + m];
                f32x4 a0, a1;
#pragma unroll
                for (int j = 0; j < 4; ++j) { a0[j] = siluf(acc[ai][0][m][0][j] * r) * (acc[ai][1][m][0][j] * r); a1[j] = siluf(acc[ai][0][m][1][j] * r) * (acc[ai][1][m][1][j] * r); }
                *(u32x4*)(O + (size_t)row * DFF + col0) = pack8(a0, a1); }
    }
};
struct EpiPle {
    static constexpr bool PERM = true, AFTER_DRAIN = false;
    float* out; const bf16_t* x2b; const bf16_t* pp; const float* part;
    __device__ __forceinline__ void operator()(const f32x4 (&acc)[2][2][4][2], const Unit& u, int wr, int wc, int fr, int fq) const {
        const int row0 = u.pm * 256 + wr * 64 + fr, col0 = u.pn * 256 + wc * 32 + 8 * fq;
        float rr[8]; rows_rs8(part, row0, fq, rr);
#pragma unroll
        for (int ai = 0; ai < 2; ++ai) {
            u32x4 pw[4][2], xw[4][2];
#pragma unroll
            for (int m = 0; m < 4; ++m)
#pragma unroll
                for (int bj = 0; bj < 2; ++bj) { const size_t off = (size_t)(row0 + ai * 128 + m * 16) * 1024 + col0 + bj * 128; pw[m][bj] = *(const u32x4*)(pp + off); xw[m][bj] = *(const u32x4*)(x2b + off); }
#pragma unroll
            for (int m = 0; m < 4; ++m) { const float r = rr[ai * 4 + m];
#pragma unroll
                for (int bj = 0; bj < 2; ++bj) { const size_t off = (size_t)(row0 + ai * 128 + m * 16) * 1024 + col0 + bj * 128;
                    f32x4 p0, p1, v0, v1; unpack8(pw[m][bj], p0, p1); unpack8(xw[m][bj], v0, v1);
#pragma unroll
                    for (int j = 0; j < 4; ++j) { v0[j] += p0[j] * sigm(acc[ai][bj][m][0][j] * r); v1[j] += p1[j] * sigm(acc[ai][bj][m][1][j] * r); }
                    *(f32x4*)(out + off) = v0; *(f32x4*)(out + off + 4) = v1; } }
        }
    }
};
}

struct Args { const float* in[21]; float* out; unsigned char* ws; };
enum { I_X = 0, I_P, I_LN1, I_WIN, I_GQ, I_GK, I_WOA, I_CONVW, I_CONVB, I_DTB, I_ALOG, I_DSKIP, I_SSMG, I_WOS, I_WOUT, I_LN2, I_WGU, I_WDN, I_LN3, I_WPG, I_WPP };

template <class MapF>
__device__ __forceinline__ void p0_transpose_item(const float* W, int K, int N, const float* gk, bf16* WT, LAS float* scr, int item, int lane, MapF map) {
    const int nblk = N / 32, kb = item / nblk, nb = item % nblk, k0 = 64 * kb, n0 = 32 * nb;
    float wv[32], gs[32];
#pragma unroll
    for (int i = 0; i < 32; ++i) wv[i] = W[(size_t)(k0 + 2 * i + (lane >> 5)) * N + n0 + (lane & 31)];
#pragma unroll
    for (int i = 0; i < 32; ++i) gs[i] = gk ? gk[k0 + 2 * i + (lane >> 5)] : 1.f;
    asm volatile("" ::: "memory");
#pragma unroll
    for (int i = 0; i < 32; ++i) { const int kk = 2 * i + (lane >> 5); scr[kk * 33 + (lane & 31)] = wv[i] * gs[i]; }
    LDS_WAIT(); asm volatile("" ::: "memory");
    const int c = lane & 7;
#pragma unroll
    for (int j = 0; j < 4; ++j) { const int n = (lane >> 3) + 8 * j; const LAS float* s = scr + (8 * c) * 33 + n;
        v4u o; o.x = pk2(s[0 * 33], s[1 * 33]); o.y = pk2(s[2 * 33], s[3 * 33]); o.z = pk2(s[4 * 33], s[5 * 33]); o.w = pk2(s[6 * 33], s[7 * 33]);
        *(v4u*)(WT + (size_t)map(n0 + n) * K + k0 + 8 * c) = o; }
    LDS_WAIT(); asm volatile("" ::: "memory");
}
struct MapId { __device__ __forceinline__ int operator()(int n) const { return n; } };
struct MapWin { __device__ __forceinline__ int operator()(int n) const {
    if (n < 2048) { const int l = n & 255; return (n & ~255) + 128 * ((l >> 5) & 1) + 32 * (l >> 6) + (l & 31); }
    if (n < 3072) return n;
    if (n < 5120) return 6144 + (n - 3072);
    if (n < 8192) return 3072 + (n - 5120);
    if (n < 8224) return 10240 + (n - 8192);
    return 8192 + (n - 8224); } };
struct MapGU { __device__ __forceinline__ int operator()(int n) const { const int up = n >= DFF ? 1 : 0, idx = n - up * DFF; return (idx >> 7) * 256 + up * 128 + (idx & 127); } };

__device__ __forceinline__ void p0_prologue(const Args& a, LAS unsigned char* lds, int gw, int NGW, int wave, int lane) {
    unsigned char* ws = a.ws;
    LAS float* scr = (LAS float*)(lds + wave * 16384);
    constexpr int I_IN = 16 * (IN_DIM / 32), I_SQ = 16 * 32, I_OS = 32 * 32, I_GU = 16 * (2 * DFF / 32), I_DN = (DFF / 64) * 32, I_PP = 4 * 32;
    constexpr int NITEMS = I_IN + 3 * I_SQ + I_OS + I_GU + I_DN + I_PP;
    for (int it = gw; it < NITEMS; it += NGW) {
        int r = it;
        if (r < I_IN) { p0_transpose_item(a.in[I_WIN], DM, IN_DIM, a.in[I_LN1], (bf16*)(ws + WS_WIN), scr, r, lane, MapWin()); continue; } r -= I_IN;
        if (r < I_SQ) { p0_transpose_item(a.in[I_WOA], DM, DM, nullptr, (bf16*)(ws + WS_WOA), scr, r, lane, MapId()); continue; } r -= I_SQ;
        if (r < I_SQ) { p0_transpose_item(a.in[I_WOUT], DM, DM, nullptr, (bf16*)(ws + WS_WOUT), scr, r, lane, MapId()); continue; } r -= I_SQ;
        if (r < I_SQ) { p0_transpose_item(a.in[I_WPG], DM, DM, a.in[I_LN3], (bf16*)(ws + WS_WPG), scr, r, lane, MapId()); continue; } r -= I_SQ;
        if (r < I_OS) { p0_transpose_item(a.in[I_WOS], SSM_IN, DM, nullptr, (bf16*)(ws + WS_WOS), scr, r, lane, MapId()); continue; } r -= I_OS;
        if (r < I_GU) { p0_transpose_item(a.in[I_WGU], DM, 2 * DFF, a.in[I_LN2], (bf16*)(ws + WS_WGU), scr, r, lane, MapGU()); continue; } r -= I_GU;
        if (r < I_DN) { p0_transpose_item(a.in[I_WDN], DFF, DM, nullptr, (bf16*)(ws + WS_WDN), scr, r, lane, MapId()); continue; } r -= I_DN;
        p0_transpose_item(a.in[I_WPP], PLE, DM, nullptr, (bf16*)(ws + WS_WPP), scr, r, lane, MapId());
    }
    float* r1 = (float*)(ws + WS_R1); bf16* xb = (bf16*)((unsigned char*)a.out + OUT_XB);
    for (int m0 = gw; m0 < M; m0 += 4 * NGW) {
        f32x4 v[4][4]; float sq[4];
#pragma unroll
        for (int r = 0; r < 4; ++r) { const int m = m0 + r * NGW; const f32x4* xr = (const f32x4*)(a.in[I_X] + (size_t)(m < M ? m : m0) * DM) + lane;
#pragma unroll
            for (int j = 0; j < 4; ++j) v[r][j] = xr[64 * j]; }
#pragma unroll
        for (int r = 0; r < 4; ++r) { float s = 0.f;
#pragma unroll
            for (int j = 0; j < 4; ++j) s += (v[r][j][0] * v[r][j][0] + v[r][j][1] * v[r][j][1]) + (v[r][j][2] * v[r][j][2] + v[r][j][3] * v[r][j][3]);
            sq[r] = s; }
#pragma unroll
        for (int o = 1; o < 64; o <<= 1) {
#pragma unroll
            for (int r = 0; r < 4; ++r) sq[r] += __shfl_xor(sq[r], o); }
#pragma unroll
        for (int r = 0; r < 4; ++r) { const int m = m0 + r * NGW; if (m < M) {
            if (lane == 0) r1[m] = rsqrtf(sq[r] * (1.f / DM) + EPS);
            unsigned long long* o8 = (unsigned long long*)(xb + (size_t)m * DM) + lane;
#pragma unroll
            for (int j = 0; j < 4; ++j) o8[64 * j] = (unsigned long long)pk2(v[r][j][0], v[r][j][1]) | ((unsigned long long)pk2(v[r][j][2], v[r][j][3]) << 32); } }
    }
    { const size_t n8 = (size_t)M * PLE / 8, st = (size_t)NGW * 64; const f32x4* ps = (const f32x4*)a.in[I_P]; v4u* pd = (v4u*)(ws + WS_PB);
      for (size_t i0 = (size_t)gw * 64 + lane; i0 < n8; i0 += 4 * st) { f32x4 a0[4], a1[4];
#pragma unroll
          for (int r = 0; r < 4; ++r) { const size_t i = i0 + r * st < n8 ? i0 + r * st : i0; a0[r] = ps[2 * i]; a1[r] = ps[2 * i + 1]; }
#pragma unroll
          for (int r = 0; r < 4; ++r) { const size_t i = i0 + r * st; if (i < n8) { v4u o; o.x = pk2(a0[r][0], a0[r][1]); o.y = pk2(a0[r][2], a0[r][3]); o.z = pk2(a1[r][0], a1[r][1]); o.w = pk2(a1[r][2], a1[r][3]); pd[i] = o; } } } }
}

__device__ __forceinline__ void dt_phase(const Args& a, LAS unsigned char* lds, int tid_, int wave_, int lane_) {
    const int wave = wave_, lane = pg8::fresh_lane(), tid = wave * 64 + lane; (void)tid_; (void)lane_;
    const bf16* xb = (const bf16*)((const unsigned char*)a.out + OUT_XB); const bf16* wdt = (const bf16*)(a.ws + WS_WIN) + (size_t)10240 * DM;
    const float* r1 = (const float*)(a.ws + WS_R1); float* dt = (float*)(a.ws + WS_DT);
    LAS float* part = (LAS float*)lds;
    const int fr = lane & 15, fq = lane >> 4;
    for (int it = blockIdx.x; it < M / 64; it += gridDim.x) {
        const bf16* ap = xb + (size_t)(it * 64 + fr) * DM + wave * 128 + 8 * fq; const bf16* bp = wdt + (size_t)fr * DM + wave * 128 + 8 * fq;
        bf16x8 af[4][4], bfr[4][2];
#pragma unroll
        for (int ks = 0; ks < 4; ++ks) {
#pragma unroll
            for (int m = 0; m < 4; ++m) af[ks][m] = *(const bf16x8*)(ap + (size_t)m * 16 * DM + ks * 32);
#pragma unroll
            for (int n = 0; n < 2; ++n) bfr[ks][n] = *(const bf16x8*)(bp + (size_t)n * 16 * DM + ks * 32); }
        f32x4 acc[4][2];
#pragma unroll
        for (int m = 0; m < 4; ++m) { acc[m][0] = (f32x4){0.f, 0.f, 0.f, 0.f}; acc[m][1] = (f32x4){0.f, 0.f, 0.f, 0.f}; }
#pragma unroll
        for (int ks = 0; ks < 4; ++ks)
#pragma unroll
            for (int m = 0; m < 4; ++m)
#pragma unroll
                for (int n = 0; n < 2; ++n) acc[m][n] = __builtin_amdgcn_mfma_f32_16x16x32_bf16(bfr[ks][n], af[ks][m], acc[m][n], 0, 0, 0);
#pragma unroll
        for (int m = 0; m < 4; ++m)
#pragma unroll
            for (int n = 0; n < 2; ++n) *(LAS f32x4*)(part + ((wave * 64 + lane) * 8 + m * 2 + n) * 4) = acc[m][n];
        __syncthreads();
        { const int l2 = tid & 63, mn = tid >> 6, m = mn >> 1, n = mn & 1, fr2 = l2 & 15, fq2 = l2 >> 4;
          f32x4 s = (f32x4){0.f, 0.f, 0.f, 0.f};
#pragma unroll
          for (int w = 0; w < 8; ++w) s += *(const LAS f32x4*)(part + ((w * 64 + l2) * 8 + mn) * 4);
          const int row = it * 64 + 16 * m + fr2; const float rs = r1[row]; const f32x4 bb = *(const f32x4*)(a.in[I_DTB] + 16 * n + 4 * fq2); f32x4 o;
#pragma unroll
          for (int j = 0; j < 4; ++j) { const float x = s[j] * rs + bb[j]; o[j] = x > 20.f ? x : log1pf(expf(x)); }
          *(f32x4*)(dt + (size_t)row * SSM_H + 16 * n + 4 * fq2) = o; }
        __syncthreads();
    }
}

constexpr int SL = 256, NCH = SEQ / SL;
constexpr size_t OUT_ST = 32 * MiB;
constexpr size_t WS_DEC = 512 * 1024;
constexpr int XT_LD = 264, BN_LD = 136;
__device__ __forceinline__ f32x4 mfma16(bf16x8 a, bf16x8 b, f32x4 c) { return __builtin_amdgcn_mfma_f32_16x16x32_bf16(a, b, c, 0, 0, 0); }
__device__ __forceinline__ void unpk8(v4u w, float (&o)[8]) {
    o[0] = __uint_as_float(w.x << 16); o[1] = __uint_as_float(w.x & 0xffff0000u); o[2] = __uint_as_float(w.y << 16); o[3] = __uint_as_float(w.y & 0xffff0000u);
    o[4] = __uint_as_float(w.z << 16); o[5] = __uint_as_float(w.z & 0xffff0000u); o[6] = __uint_as_float(w.w << 16); o[7] = __uint_as_float(w.w & 0xffff0000u); }
template <int NR> __device__ __forceinline__ void conv_load(const bf16* xb, int t0, v4u (&raw)[NR + 3]) {
#pragma unroll
    for (int i = 0; i < NR + 3; ++i) { const int t = t0 - 3 + i; raw[i] = t >= 0 ? *(const v4u*)(xb + (size_t)t * CONVD) : (v4u){0u, 0u, 0u, 0u}; }
}
struct ConvW { float w[4][8], bias[8]; };
__device__ __forceinline__ void conv_loadw(const float* cw, const float* cb, int ch0, ConvW& c) {
#pragma unroll
    for (int k = 0; k < 4; ++k) { const f32x4 x0 = *(const f32x4*)(cw + (size_t)k * CONVD + ch0), x1 = *(const f32x4*)(cw + (size_t)k * CONVD + ch0 + 4);
        c.w[k][0] = x0[0]; c.w[k][1] = x0[1]; c.w[k][2] = x0[2]; c.w[k][3] = x0[3]; c.w[k][4] = x1[0]; c.w[k][5] = x1[1]; c.w[k][6] = x1[2]; c.w[k][7] = x1[3]; }
    { const f32x4 x0 = *(const f32x4*)(cb + ch0), x1 = *(const f32x4*)(cb + ch0 + 4); c.bias[0] = x0[0]; c.bias[1] = x0[1]; c.bias[2] = x0[2]; c.bias[3] = x0[3]; c.bias[4] = x1[0]; c.bias[5] = x1[1]; c.bias[6] = x1[2]; c.bias[7] = x1[3]; }
}
template <int NR> __device__ __forceinline__ void conv_compute_w(const v4u (&raw)[NR + 3], const ConvW& c, float (&out)[NR][8]) {
    float r0[8], r1[8], r2[8], cur[8];
    unpk8(raw[0], r0); unpk8(raw[1], r1); unpk8(raw[2], r2);
#pragma unroll
    for (int r = 0; r < NR; ++r) {
        unpk8(raw[r + 3], cur);
#pragma unroll
        for (int i = 0; i < 8; ++i) { const float v = c.bias[i] + c.w[0][i] * r0[i] + c.w[1][i] * r1[i] + c.w[2][i] * r2[i] + c.w[3][i] * cur[i]; out[r][i] = siluf(v); r0[i] = r1[i]; r1[i] = r2[i]; r2[i] = cur[i]; }
    }
}
template <int NR> __device__ __forceinline__ void conv_compute(const v4u (&raw)[NR + 3], const float* cw, const float* cb, int ch0, float (&out)[NR][8]) { ConvW c; conv_loadw(cw, cb, ch0, c); conv_compute_w<NR>(raw, c, out); }
template <int NR> __device__ __forceinline__ void conv8(const bf16* xb, int t0, const float* cw, const float* cb, int ch0, float (&out)[NR][8]) { v4u raw[NR + 3]; conv_load<NR>(xb, t0, raw); conv_compute<NR>(raw, cw, cb, ch0, out); }
__device__ __forceinline__ float ssd_dt_scan(const Args& a, size_t row0, int h, int lane, float (&d)[4], float (&acs)[4]) {
    const float* DT = (const float*)(a.ws + WS_DT); const float A = -expf(a.in[I_ALOG][h]);
#pragma unroll
    for (int i = 0; i < 4; ++i) d[i] = DT[(row0 + 4 * lane + i) * SSM_H + h];
    const float s1 = d[0] * A, s2 = s1 + d[1] * A, s3 = s2 + d[2] * A, s4 = s3 + d[3] * A;
    float incl = s4;
#pragma unroll
    for (int o = 1; o < 64; o <<= 1) { const float t = __shfl_up(incl, o); if (lane >= o) incl += t; }
    const float excl = incl - s4;
    acs[0] = excl + s1; acs[1] = excl + s2; acs[2] = excl + s3; acs[3] = excl + s4;
    return __shfl(incl, 63);
}
constexpr int S1_W = 0, S1_B = 8192, S1_X = 8192 + 67584;
__device__ __forceinline__ void st_rows8(bf16* dst, bf16* tl, int r0, const float (&o)[8][8]) {
#pragma unroll
    for (int r = 0; r < 8; ++r) { v4u w; w.x = pk2(o[r][0], o[r][1]); w.y = pk2(o[r][2], o[r][3]); w.z = pk2(o[r][4], o[r][5]); w.w = pk2(o[r][6], o[r][7]);
        bf16* p = (r >= 5 && r0 + r >= 253) ? tl + (size_t)(r0 + r - 253) * CONVD : dst + (size_t)r * CONVD; *(v4u*)p = w; }
}
__device__ __forceinline__ void ssd_s1(const Args& a, LAS unsigned char* lds, int tid_, int wave_, int lane_) {
    const int wave = wave_, lane = pg8::fresh_lane(), tid = wave * 64 + lane; (void)tid_; (void)lane_;
    bf16* XBC = (bf16*)(a.ws + WS_XBC); bf16* TAIL = (bf16*)(a.ws + WS_TAIL); bf16* ST = (bf16*)((unsigned char*)a.out + OUT_ST); float* DEC = (float*)(a.ws + WS_DEC);
    LAS float* W8 = (LAS float*)(lds + S1_W); LAS bf16* BT = (LAS bf16*)(lds + S1_B); LAS bf16* XT = (LAS bf16*)(lds + S1_X);
    const int fr = lane & 15, fq = lane >> 4, chunk = tid & 15, r0 = 8 * (tid >> 4);
    for (int unit = blockIdx.x; unit < BATCH * NCH * SSM_G; unit += gridDim.x) {
        const int g = unit & 3, c = (unit >> 2) & 31, b = unit >> 7; const size_t rowb = (size_t)b * SEQ; const int t0c = c * SL;
        bf16* xrow = XBC + rowb * CONVD; bf16* tlb = TAIL + (size_t)((b * NCH + c) * 3) * CONVD;
        v4u raw[11]; ConvW cwx;
        { const int ch0 = g * 512 + (chunk >> 3) * 64 + 8 * (chunk & 7); conv_load<8>(xrow + ch0, t0c + r0, raw); }
        { const int h = g * 8 + wave; float d[4], acs[4]; const float tot = ssd_dt_scan(a, rowb + t0c, h, lane, d, acs); if (lane == 0) DEC[(b * NCH + c) * 32 + h] = expf(tot);
          *(LAS f32x4*)(W8 + wave * 256 + 4 * lane) = (f32x4){d[0] * __expf(tot - acs[0]), d[1] * __expf(tot - acs[1]), d[2] * __expf(tot - acs[2]), d[3] * __expf(tot - acs[3])}; }
        { const int ch0 = 2048 + g * 128 + 8 * chunk; float o[8][8]; v4u rawb[11];
          conv_load<8>(xrow + ch0, t0c + r0, rawb); ConvW cwb; conv_loadw(a.in[I_CONVW], a.in[I_CONVB], ch0, cwb);
          asm volatile("s_waitcnt vmcnt(0)" ::: "memory"); __syncthreads();
          conv_compute_w<8>(rawb, cwb, o);
#pragma unroll
          for (int i = 0; i < 8; ++i) { v4u w; w.x = pk2(o[0][i], o[1][i]); w.y = pk2(o[2][i], o[3][i]); w.z = pk2(o[4][i], o[5][i]); w.w = pk2(o[6][i], o[7][i]); *(LAS v4u*)(BT + (8 * chunk + i) * XT_LD + r0) = w; }
          st_rows8(xrow + (size_t)(t0c + r0) * CONVD + ch0, tlb + ch0, r0, o); }
        conv_loadw(a.in[I_CONVW], a.in[I_CONVB], g * 512 + (chunk >> 3) * 64 + 8 * (chunk & 7), cwx);
        __syncthreads();
        for (int pr = 0; pr < 4; ++pr) {
            { const int hj = 2 * pr + (chunk >> 3), ch0 = g * 512 + hj * 64 + 8 * (chunk & 7); float o[8][8];
              conv_compute_w<8>(raw, cwx, o);
              st_rows8(xrow + (size_t)(t0c + r0) * CONVD + ch0, tlb + ch0, r0, o);
#pragma unroll
              for (int r = 0; r < 8; ++r) { const float wgt = W8[hj * 256 + r0 + r];
#pragma unroll
                  for (int i = 0; i < 8; ++i) o[r][i] *= wgt; }
#pragma unroll
              for (int i = 0; i < 8; ++i) { v4u w; w.x = pk2(o[0][i], o[1][i]); w.y = pk2(o[2][i], o[3][i]); w.z = pk2(o[4][i], o[5][i]); w.w = pk2(o[6][i], o[7][i]); *(LAS v4u*)(XT + (8 * chunk + i) * XT_LD + r0) = w; } }
            __syncthreads();
            { const int ch0 = pr < 3 ? g * 512 + (2 * pr + 2 + (chunk >> 3)) * 64 + 8 * (chunk & 7) : 2560 + g * 128 + 8 * chunk;
              conv_load<8>(xrow + ch0, t0c + r0, raw); conv_loadw(a.in[I_CONVW], a.in[I_CONVB], ch0, cwx); }
            const int e = wave >> 2, pt = wave & 3, h = g * 8 + 2 * pr + e;
            f32x4 acc[8];
#pragma unroll
            for (int nt = 0; nt < 8; ++nt) acc[nt] = (f32x4){0.f, 0.f, 0.f, 0.f};
            { bf16x8 xf[2], bfr[2][8];
#define S1_LD(ks_, set_) do { xf[set_] = *(const LAS bf16x8*)(XT + (e * 64 + pt * 16 + fr) * XT_LD + 32 * (ks_) + 8 * fq); \
                _Pragma("unroll") for (int nt = 0; nt < 8; ++nt) bfr[set_][nt] = *(const LAS bf16x8*)(BT + (nt * 16 + fr) * XT_LD + 32 * (ks_) + 8 * fq); } while (0)
              S1_LD(0, 0);
#pragma unroll
              for (int ks = 0; ks < 8; ++ks) {
                  if (ks < 7) S1_LD(ks + 1, (ks + 1) & 1);
                  asm volatile("" ::: "memory");
#pragma unroll
                  for (int nt = 0; nt < 8; ++nt) acc[nt] = mfma16(bfr[ks & 1][nt], xf[ks & 1], acc[nt]);
              }
#undef S1_LD
            }
            bf16* dst = ST + ((((size_t)b * 32 + h) * NCH + c) * 64 + pt * 16 + fr) * 128 + 4 * fq;
#pragma unroll
            for (int nt = 0; nt < 8; ++nt) *(unsigned long long*)(dst + nt * 16) = (unsigned long long)pk2(acc[nt][0], acc[nt][1]) | ((unsigned long long)pk2(acc[nt][2], acc[nt][3]) << 32);
            asm volatile("s_waitcnt vmcnt(0)" ::: "memory");
            __syncthreads();
        }
        { const int ch0 = 2560 + g * 128 + 8 * chunk; float o[8][8];
          conv_compute_w<8>(raw, cwx, o);
          st_rows8(xrow + (size_t)(t0c + r0) * CONVD + ch0, tlb + ch0, r0, o); }
    }
}
__device__ __forceinline__ void ssd_s2(const Args& a, int tid_) {
    const int tid = tid_;
    unsigned long long* ST = (unsigned long long*)((unsigned char*)a.out + OUT_ST); const float* DEC = (const float*)(a.ws + WS_DEC);
    for (int e = blockIdx.x * NTHR + tid; e < BATCH * 32 * 2048; e += gridDim.x * NTHR) {
        const int b = e >> 16, h = (e >> 11) & 31, q4 = e & 2047;
        unsigned long long* p = ST + ((size_t)(b * 32 + h) * NCH) * 2048 + q4; constexpr size_t cst = 2048;
        unsigned long long w[NCH]; float dv[NCH];
#pragma unroll
        for (int c = 0; c < NCH; ++c) w[c] = p[c * cst];
#pragma unroll
        for (int c = 0; c < NCH; ++c) dv[c] = DEC[(b * NCH + c) * 32 + h];
        asm volatile("" ::: "memory");
        float s0 = 0.f, s1 = 0.f, s2 = 0.f, s3 = 0.f;
#pragma unroll
        for (int c = 0; c < NCH; ++c) { const float dec = dv[c];
            p[c * cst] = (unsigned long long)pk2(s0, s1) | ((unsigned long long)pk2(s2, s3) << 32);
            const unsigned lo = (unsigned)w[c], hi = (unsigned)(w[c] >> 32);
            s0 = s0 * dec + __uint_as_float(lo << 16); s1 = s1 * dec + __uint_as_float(lo & 0xffff0000u); s2 = s2 * dec + __uint_as_float(hi << 16); s3 = s3 * dec + __uint_as_float(hi & 0xffff0000u); }
    }
}
constexpr int S3_BSZ = 73728  , S3_ACS = 0, S3_DTS = 8192, S3_SSQ = 16384, S3_B = 17408, S3_X = 17408 + S3_BSZ, S3_P = 17408 + S3_BSZ + 34816, S3_W3 = 17408 + S3_BSZ + 34816 + 16384, S3_P2 = S3_W3 + 1024;
__device__ __forceinline__ void ssd_s3(const Args& a, LAS unsigned char* lds, int tid_, int wave_, int lane_) {
    const int wave = wave_, lane = pg8::fresh_lane(), tid = wave * 64 + lane; (void)tid_; (void)lane_;
    const bf16* XBC = (const bf16*)(a.ws + WS_XBC); const bf16* ST = (const bf16*)((const unsigned char*)a.out + OUT_ST); bf16* Z = (bf16*)(a.ws + WS_Z);
    LAS float* acsL = (LAS float*)(lds + S3_ACS); LAS float* dtsL = (LAS float*)(lds + S3_DTS); LAS float* ssq = (LAS float*)(lds + S3_SSQ);
    LAS bf16* Bn = (LAS bf16*)(lds + S3_B); LAS bf16* XT = (LAS bf16*)(lds + S3_X); LAS float* W3 = (LAS float*)(lds + S3_W3);
    const int fr = lane & 15, fq = lane >> 4, xchunk = tid & 7, xr0 = 4 * (tid >> 3);
    for (int unit = blockIdx.x; unit < BATCH * NCH * SSM_G; unit += gridDim.x) {
        const int g = unit & 3, c = (unit >> 2) & 31, b = unit >> 7; const size_t rowb = (size_t)b * SEQ; const int t0c = c * SL;
        const bf16* tlb = (const bf16*)(a.ws + WS_TAIL) + (size_t)((b * NCH + c) * 3) * CONVD;
        { float d[4], acs[4]; (void)ssd_dt_scan(a, rowb + t0c, g * 8 + wave, lane, d, acs);
          constexpr float L2E = 1.4426950408889634f; *(LAS f32x4*)(acsL + wave * 256 + 4 * lane) = (f32x4){acs[0] * L2E, acs[1] * L2E, acs[2] * L2E, acs[3] * L2E}; *(LAS f32x4*)(dtsL + wave * 256 + 4 * lane) = (f32x4){d[0], d[1], d[2], d[3]}; }
        if (tid < 256) ssq[tid] = 0.f;
        bf16x8 cf[2][4];
#pragma unroll
        for (int st = 0; st < 2; ++st) {
            { const int t2 = tid & 255, chunk = t2 & 15, r0 = 8 * (t2 >> 4);
              const bool isC = tid < 256; const int rr = isC ? st * 128 + r0 : st * 128 + r0, ch0 = (isC ? 2560 : 2048) + g * 128 + 8 * chunk;
              const bf16* src = XBC + (rowb + t0c + rr) * CONVD + ch0; v4u w[8];
#pragma unroll
              for (int r = 0; r < 8; ++r) w[r] = *(const v4u*)((r >= 5 && rr + r >= 253) ? tlb + (size_t)(rr + r - 253) * CONVD + ch0 : src + (size_t)r * CONVD);
              LAS bf16* dstl = isC ? XT + r0 * BN_LD + 8 * chunk : Bn + (st * 128 + r0) * BN_LD + 8 * chunk;
#pragma unroll
              for (int r = 0; r < 8; ++r) *(LAS v4u*)(dstl + r * BN_LD) = w[r]; }
            __syncthreads();
            { const int lrel = (st ? 15 - wave : wave) * 16 - st * 128 + fr;
#pragma unroll
              for (int ks = 0; ks < 4; ++ks) cf[st][ks] = *(const LAS bf16x8*)(XT + lrel * BN_LD + 32 * ks + 8 * fq); }
            __syncthreads();
        }
        LAS unsigned char* SW = lds + S3_B + wave * 9216 + lane * 16;
        {   v4u stw[9];
#pragma unroll
            for (int q = 0; q < 9; ++q) {
                const int n0 = (wave >> 1) + 1, st = q < n0 ? 0 : 1, t = st ? q - n0 : q, s0 = 32 * t;
                f32x4 sa = (f32x4){0.f, 0.f, 0.f, 0.f}, sb = sa;
                bf16x8 b0[4], b1[4];
#pragma unroll
                for (int ks = 0; ks < 4; ++ks) { b0[ks] = *(const LAS bf16x8*)(Bn + (s0 + fr) * BN_LD + 32 * ks + 8 * fq); b1[ks] = *(const LAS bf16x8*)(Bn + (s0 + 16 + fr) * BN_LD + 32 * ks + 8 * fq); }
                asm volatile("" ::: "memory");
#pragma unroll
                for (int ks = 0; ks < 4; ++ks) { const bf16x8 c0 = st ? cf[1][ks] : cf[0][ks];
                    sa = mfma16(b0[ks], c0, sa); sb = mfma16(b1[ks], c0, sb); }
                stw[q].x = pk2(sa[0], sa[1]); stw[q].y = pk2(sa[2], sa[3]); stw[q].z = pk2(sb[0], sb[1]); stw[q].w = pk2(sb[2], sb[3]);
            }
            __syncthreads();
#pragma unroll
            for (int q = 0; q < 9; ++q) *(LAS v4u*)(SW + q * 1024) = stw[q];
        }
        v4u raw[4];
#define S3_LDX(jj) do { const int ch_ = g * 512 + (jj) * 64 + 8 * xchunk; const bf16* xs_ = XBC + (rowb + t0c + xr0) * CONVD + ch_; \
            _Pragma("unroll") for (int r = 0; r < 4; ++r) raw[r] = *(const v4u*)((r >= 1 && xr0 + r >= 253) ? tlb + (size_t)(xr0 + r - 253) * CONVD + ch_ : xs_ + (size_t)r * CONVD); } while (0)
        S3_LDX(0);
#define S3_DMA(jj) do { const bf16* pvg_ = ST + ((((size_t)b * 32 + g * 8 + (jj)) * NCH + c) * 64) * 128; LAS unsigned char* pvl_ = lds + (((jj) & 1) ? S3_P2 : S3_P); \
            _Pragma("unroll") for (int i = 0; i < 2; ++i) { const int L = i * 512 + tid, row = L >> 4, cpos = L & 15; \
                __builtin_amdgcn_global_load_lds((const unsigned*)(pvg_ + (size_t)row * 128 + 8 * (cpos ^ (row & 15))), (__attribute__((address_space(3))) unsigned*)(pvl_ + (i * 512 + wave * 64) * 16), 16, 0, 0); } } while (0)
        S3_DMA(0);
        for (int j = 0; j < 8; ++j) {
            const int h = g * 8 + j; const float Dj = a.in[I_DSKIP][h];
            LAS unsigned char* PV = lds + ((j & 1) ? S3_P2 : S3_P);
            if (tid < 256) W3[tid] = dtsL[j * 256 + tid] * __builtin_amdgcn_exp2f(acsL[j * 256 + (tid | 31)] - acsL[j * 256 + tid]);
            {
#pragma unroll
                for (int i2 = 0; i2 < 4; ++i2) {
                    const unsigned a0 = raw[0][i2], a1 = raw[1][i2], a2 = raw[2][i2], a3 = raw[3][i2];
                    const unsigned e01 = __builtin_amdgcn_perm(a1, a0, 0x05040100u), e23 = __builtin_amdgcn_perm(a3, a2, 0x05040100u);
                    const unsigned o01 = __builtin_amdgcn_perm(a1, a0, 0x07060302u), o23 = __builtin_amdgcn_perm(a3, a2, 0x07060302u);
                    *(LAS unsigned long long*)(XT + (8 * xchunk + 2 * i2) * XT_LD + xr0) = (unsigned long long)e01 | ((unsigned long long)e23 << 32);
                    *(LAS unsigned long long*)(XT + (8 * xchunk + 2 * i2 + 1) * XT_LD + xr0) = (unsigned long long)o01 | ((unsigned long long)o23 << 32); } }
            __syncthreads();
            if (j < 7) { S3_DMA(j + 1); S3_LDX(j + 1); }
            unsigned long long zw[2][4];
#pragma unroll
            for (int st = 0; st < 2; ++st) { const int l = (st ? 15 - wave : wave) * 16 + fr; const bf16* zp = Z + (rowb + t0c + l) * SSM_IN + h * 64 + 4 * fq;
#pragma unroll
                for (int pt = 0; pt < 4; ++pt) zw[st][pt] = *(const unsigned long long*)(zp + pt * 16); }
#pragma unroll
            for (int st = 0; st < 2; ++st) {
                const int strip = st ? 15 - wave : wave, l = strip * 16 + fr;
                f32x4 y[4];
#pragma unroll
                for (int pt = 0; pt < 4; ++pt) y[pt] = (f32x4){0.f, 0.f, 0.f, 0.f};
                { bf16x8 pf[2][4];
#define S3_PLD(ks_, set_) do { _Pragma("unroll") for (int pt = 0; pt < 4; ++pt) { const int prow = pt * 16 + fr; pf[set_][pt] = *(const LAS bf16x8*)(PV + prow * 256 + (((4 * (ks_) + fq) ^ (prow & 15)) << 4)); } } while (0)
                  S3_PLD(0, 0);
#pragma unroll
                  for (int ks = 0; ks < 4; ++ks) {
                      if (ks < 3) S3_PLD(ks + 1, (ks + 1) & 1);
                      asm volatile("" ::: "memory");
#pragma unroll
                      for (int pt = 0; pt < 4; ++pt) y[pt] = mfma16(pf[ks & 1][pt], cf[st][ks], y[pt]);
                  }
#undef S3_PLD
                }
                const float al = acsL[j * 256 + l], el = __builtin_amdgcn_exp2f(al);
#pragma unroll
                for (int pt = 0; pt < 4; ++pt) y[pt] = y[pt] * el;
                const int nst = (strip >> 1) + 1;
                for (int t = 0; t < nst; ++t) { const int s0 = 32 * t;
                    const v4u sw = *(const LAS v4u*)(SW + ((st ? (wave >> 1) + 1 : 0) + t) * 1024);
                    unsigned long long xlo[4], xhi[4];
#pragma unroll
                    for (int pt = 0; pt < 4; ++pt) { const LAS bf16* xr = XT + (pt * 16 + fr) * XT_LD + s0 + 4 * fq; xlo[pt] = *(const LAS unsigned long long*)xr; xhi[pt] = *(const LAS unsigned long long*)(xr + 16); }
                    const bool fast = t < nst - 1;
                    const f32x4 wa = *(const LAS f32x4*)((fast ? W3 : acsL + j * 256) + s0 + 4 * fq), wb = *(const LAS f32x4*)((fast ? W3 : acsL + j * 256) + s0 + 16 + 4 * fq);
                    const float aref = acsL[j * 256 + s0 + 31];
                    f32x4 dta = (f32x4){0.f, 0.f, 0.f, 0.f}, dtb = dta;
                    if (!fast) { dta = *(const LAS f32x4*)(dtsL + j * 256 + s0 + 4 * fq); dtb = *(const LAS f32x4*)(dtsL + j * 256 + s0 + 16 + 4 * fq); }
                    asm volatile("" ::: "memory");
                    float sa[4], sb[4];
                    sa[0] = __uint_as_float(sw.x << 16); sa[1] = __uint_as_float(sw.x & 0xffff0000u); sa[2] = __uint_as_float(sw.y << 16); sa[3] = __uint_as_float(sw.y & 0xffff0000u);
                    sb[0] = __uint_as_float(sw.z << 16); sb[1] = __uint_as_float(sw.z & 0xffff0000u); sb[2] = __uint_as_float(sw.w << 16); sb[3] = __uint_as_float(sw.w & 0xffff0000u);
                    float pa[4], pb[4];
                    if (fast) {
                        const float u = __builtin_amdgcn_exp2f(al - aref);
#pragma unroll
                        for (int r = 0; r < 4; ++r) { pa[r] = sa[r] * (wa[r] * u); pb[r] = sb[r] * (wb[r] * u); }
                    } else {
#pragma unroll
                        for (int r = 0; r < 4; ++r) { const int s = s0 + 4 * fq + r;
                            float v = sa[r] * __builtin_amdgcn_exp2f(al - wa[r]) * dta[r]; v = s <= l ? v : 0.f; if (s == l) v += Dj; pa[r] = v;
                            float u2 = sb[r] * __builtin_amdgcn_exp2f(al - wb[r]) * dtb[r]; u2 = s + 16 <= l ? u2 : 0.f; if (s + 16 == l) u2 += Dj; pb[r] = u2; }
                    }
                    v4u pw; pw.x = pk2(pa[0], pa[1]); pw.y = pk2(pa[2], pa[3]); pw.z = pk2(pb[0], pb[1]); pw.w = pk2(pb[2], pb[3]);
                    const bf16x8 pfrag = __builtin_bit_cast(bf16x8, pw);
#pragma unroll
                    for (int pt = 0; pt < 4; ++pt) { v4u xw; xw.x = (unsigned)xlo[pt]; xw.y = (unsigned)(xlo[pt] >> 32); xw.z = (unsigned)xhi[pt]; xw.w = (unsigned)(xhi[pt] >> 32);
                        y[pt] = mfma16(__builtin_bit_cast(bf16x8, xw), pfrag, y[pt]); }
                }
                bf16* zp = Z + (rowb + t0c + l) * SSM_IN + h * 64 + 4 * fq; float sq = 0.f;
#pragma unroll
                for (int pt = 0; pt < 4; ++pt) { const unsigned lo = (unsigned)zw[st][pt], hi = (unsigned)(zw[st][pt] >> 32);
                    const float g0 = y[pt][0] * __uint_as_float(lo << 16), g1 = y[pt][1] * __uint_as_float(lo & 0xffff0000u), g2 = y[pt][2] * __uint_as_float(hi << 16), g3 = y[pt][3] * __uint_as_float(hi & 0xffff0000u);
                    sq += (g0 * g0 + g1 * g1) + (g2 * g2 + g3 * g3);
                    *(unsigned long long*)(zp + pt * 16) = (unsigned long long)pk2(g0, g1) | ((unsigned long long)pk2(g2, g3) << 32); }
                sq += __shfl_xor(sq, 16); sq += __shfl_xor(sq, 32);
                if (fq == 0) ssq[l] += sq;
            }
            __syncthreads();
        }
        {
            const int ck = tid & 63, rw0 = tid >> 6;
            const f32x4 g0 = *(const f32x4*)(a.in[I_SSMG] + g * 512 + 8 * ck), g1 = *(const f32x4*)(a.in[I_SSMG] + g * 512 + 8 * ck + 4);
            bf16* pz = Z + (rowb + t0c + rw0) * SSM_IN + g * 512 + 8 * ck;
            for (int i0 = 0; i0 < SL / 8; i0 += 4) {
                v4u w[4]; float r[4];
#pragma unroll
                for (int i = 0; i < 4; ++i) w[i] = *(const v4u*)(pz + (size_t)(i0 + i) * 8 * SSM_IN);
#pragma unroll
                for (int i = 0; i < 4; ++i) r[i] = rsqrtf(ssq[rw0 + 8 * (i0 + i)] * (1.f / 512.f) + EPS);
                asm volatile("" ::: "memory");
#pragma unroll
                for (int i = 0; i < 4; ++i) { f32x4 v0, v1; ep::unpack8(w[i], v0, v1); *(v4u*)(pz + (size_t)(i0 + i) * 8 * SSM_IN) = ep::pack8(v0 * r[i] * g0, v1 * r[i] * g1); }
            }
        }
        __syncthreads();
    }
}

__device__ __forceinline__ int crow(int r, int hi) { return (r & 3) + 8 * (r >> 2) + 4 * hi; }
typedef float f32x16 __attribute__((ext_vector_type(16)));
constexpr int AL_SLOT = 0, AL_LACC = 131072, AL_SEL = 135168, AL_CNT = 138240, AL_OFFS = 138368, AL_FILL = 138624, AL_LIST = 138880, AL_ITEMS = 141952, AL_CTL = 142976, AL_KS = 0;
typedef long i64_t;
__device__ __forceinline__ i64_t pack_p8(const float* p) { int w0 = 0, w1 = 0;
    w0 = __builtin_amdgcn_cvt_pk_bf8_f32(p[0], p[1], w0, false); w0 = __builtin_amdgcn_cvt_pk_bf8_f32(p[2], p[3], w0, true);
    w1 = __builtin_amdgcn_cvt_pk_bf8_f32(p[4], p[5], w1, false); w1 = __builtin_amdgcn_cvt_pk_bf8_f32(p[6], p[7], w1, true); return (i64_t)(((unsigned long long)(unsigned)w1 << 32) | (unsigned)w0); }
__device__ __forceinline__ i64_t cvt_q8(bf16x8 q, float sc) { float f[8]; unpk8(__builtin_bit_cast(v4u, q), f); int w0 = 0, w1 = 0;
    w0 = __builtin_amdgcn_cvt_pk_fp8_f32(f[0] * sc, f[1] * sc, w0, false); w0 = __builtin_amdgcn_cvt_pk_fp8_f32(f[2] * sc, f[3] * sc, w0, true);
    w1 = __builtin_amdgcn_cvt_pk_fp8_f32(f[4] * sc, f[5] * sc, w1, false); w1 = __builtin_amdgcn_cvt_pk_fp8_f32(f[6] * sc, f[7] * sc, w1, true); return (i64_t)(((unsigned long long)(unsigned)w1 << 32) | (unsigned)w0); }
__device__ __forceinline__ bf16x8 pack_p(const float* p) { v4u w; w.x = pk2(p[0], p[1]); w.y = pk2(p[2], p[3]); w.z = pk2(p[4], p[5]); w.w = pk2(p[6], p[7]); return __builtin_bit_cast(bf16x8, w); }
__device__ __forceinline__ void attn_mfma(const Args& a, LAS unsigned char* lds, int tid_, int wave_, int lane_, bf16* AO, bool dynq, unsigned* qcnt) {
    const int wave = wave_, lane = pg8::fresh_lane(), tid = wave * 64 + lane; (void)tid_; (void)lane_;
    const unsigned char* K8 = a.ws + WS_K; const bf16* Vt = (const bf16*)(a.ws + WS_V); const bf16* Q = (const bf16*)(a.ws + WS_Q);
    const float* ksum = (const float*)(a.ws + WS_KMEAN);
    LAS unsigned char* SLOT = lds + AL_SLOT; LAS float* LACC = (LAS float*)(lds + AL_LACC); LAS int* SEL = (LAS int*)(lds + AL_SEL);
    LAS int* CNT = (LAS int*)(lds + AL_CNT); LAS int* OFFS = (LAS int*)(lds + AL_OFFS); LAS int* FILL = (LAS int*)(lds + AL_FILL); LAS int* LIST = (LAS int*)(lds + AL_LIST);
    LAS int* ITEMS = (LAS int*)(lds + AL_ITEMS); LAS int* CTL = (LAS int*)(lds + AL_CTL); LAS float* KS = (LAS float*)(lds + AL_KS);
    float gqm = 0.f, gkm = 0.f;
    for (int d = 0; d < HD; ++d) { gqm = fmaxf(gqm, fabsf(a.in[I_GQ][d])); gkm = fmaxf(gkm, fabsf(a.in[I_GK][d])); }
    constexpr float C1 = 0.125f * 1.4426950408889634f;
    const float c0 = 8.f * gqm * gkm * 1.4426950408889634f;
    const int qi = tid >> 1, hf = tid & 1, c32 = lane & 31, hi = lane >> 5;
    const int pi32 = (c32 & ~12) | ((c32 & 4) << 1) | ((c32 & 8) >> 1);
    const bool xcd_order = (gridDim.x == 256);
    for (int ui = 0; ; ++ui) {
        int bh, own;
        if (dynq) {
            if (wave == 0 && pg8::fresh_lane() == 0) CTL[2] = (int)__hip_atomic_fetch_add(qcnt, 1u, __ATOMIC_RELAXED, __HIP_MEMORY_SCOPE_AGENT);
            __syncthreads();
            const int uq = __builtin_amdgcn_readfirstlane(CTL[2]);
            __syncthreads();
            if (uq >= 128) break;
            bh = (int)(blockIdx.x & 7) + 8 * (uq >> 5); own = 31 - (uq & 31);
        } else if (xcd_order) { if (ui >= 4) break; bh = (int)(blockIdx.x & 7) + 8 * ui; const int k5 = (int)(blockIdx.x >> 3), ka = (ui & 2) ? ((k5 + 16) & 31) : k5; own = (ui & 1) ? 31 - ka : ka; }
        else { const int unit = (int)blockIdx.x + ui * (int)gridDim.x; if (unit >= BATCH * NH * NBLK) break; bh = unit & 31; own = unit >> 5; }
        const int b = bh >> 4, h = bh & 15;
        const size_t rowq0 = (size_t)b * SEQ + own * BLK;
        const int tidb = wave * 64 + pg8::fresh_lane(), laneb = tidb & 63;
        if (tidb < 32) { CNT[tidb] = 0; FILL[tidb] = 0; }
        {
            const bf16* qp = Q + (rowq0 + 32 * wave + c32) * DM + h * HD + 8 * hi;
            const float* kr = ksum + ((size_t)(b * NH + h) * NBLK + c32) * 128 + 8 * hi;
            f32x16 gs;
#pragma unroll
            for (int r = 0; r < 16; ++r) gs[r] = 0.f;
            bf16x8 qfs[4]; f32x4 ka[4][2], kb[4][2];
            { const float* krs = c32 < own ? kr : kr - (size_t)c32 * 128;
#pragma unroll
              for (int s = 0; s < 4; ++s) { qfs[s] = *(const bf16x8*)(qp + 16 * s); ka[s][0] = *(const f32x4*)(krs + 16 * s); ka[s][1] = *(const f32x4*)(krs + 16 * s + 4); kb[s][0] = *(const f32x4*)(krs + 64 + 16 * s); kb[s][1] = *(const f32x4*)(krs + 64 + 16 * s + 4); } }
            asm volatile("" ::: "memory");
#pragma unroll
            for (int s = 0; s < 4; ++s) {
                const bf16x8 qf = qfs[s];
                f32x4 k0 = (f32x4){0.f, 0.f, 0.f, 0.f}, k1 = k0;
                if (c32 < own) { k0 = ka[s][0] + kb[s][0]; k1 = ka[s][1] + kb[s][1]; }
                v4u whi; whi.x = pk2(k0[0], k0[1]); whi.y = pk2(k0[2], k0[3]); whi.z = pk2(k1[0], k1[1]); whi.w = pk2(k1[2], k1[3]);
                float hv[8]; unpk8(whi, hv);
                v4u wlo; wlo.x = pk2(k0[0] - hv[0], k0[1] - hv[1]); wlo.y = pk2(k0[2] - hv[2], k0[3] - hv[3]); wlo.z = pk2(k1[0] - hv[4], k1[1] - hv[5]); wlo.w = pk2(k1[2] - hv[6], k1[3] - hv[7]);
                gs = __builtin_amdgcn_mfma_f32_32x32x16_bf16(__builtin_bit_cast(bf16x8, whi), qf, gs, 0, 0, 0);
                gs = __builtin_amdgcn_mfma_f32_32x32x16_bf16(__builtin_bit_cast(bf16x8, wlo), qf, gs, 0, 0, 0);
            }
            float bv0 = -INFINITY, bv1 = -INFINITY, bv2 = -INFINITY; int bi0 = -1, bi1 = -1, bi2 = -1;
            int hig = hi; asm volatile("" : "+v"(hig));
#pragma unroll
            for (int r = 0; r < 16; ++r) { const int n = crow(r, hig); const float gsc = gs[r];
                if (n < own) {
                    if (gsc > bv0) { bv2 = bv1; bi2 = bi1; bv1 = bv0; bi1 = bi0; bv0 = gsc; bi0 = n; }
                    else if (gsc > bv1) { bv2 = bv1; bi2 = bi1; bv1 = gsc; bi1 = n; }
                    else if (gsc > bv2) { bv2 = gsc; bi2 = n; } } }
            const float pv0 = __shfl_xor(bv0, 32), pv1 = __shfl_xor(bv1, 32), pv2 = __shfl_xor(bv2, 32); const int pi0 = __shfl_xor(bi0, 32), pi1 = __shfl_xor(bi1, 32), pi2 = __shfl_xor(bi2, 32);
#pragma unroll
            for (int t = 0; t < 3; ++t) { const float cv = t == 0 ? pv0 : t == 1 ? pv1 : pv2; const int ci = t == 0 ? pi0 : t == 1 ? pi1 : pi2;
                if (ci >= 0) {
                    if (cv > bv0 || (cv == bv0 && ci < bi0)) { bv2 = bv1; bi2 = bi1; bv1 = bv0; bi1 = bi0; bv0 = cv; bi0 = ci; }
                    else if (cv > bv1 || (cv == bv1 && (bi1 < 0 || ci < bi1))) { bv2 = bv1; bi2 = bi1; bv1 = cv; bi1 = ci; }
                    else if (cv > bv2 || (cv == bv2 && (bi2 < 0 || ci < bi2))) { bv2 = cv; bi2 = ci; } } }
            if (hi == 0) { const int qq = 32 * wave + c32; SEL[qq * 3 + 0] = bi0; SEL[qq * 3 + 1] = bi1; SEL[qq * 3 + 2] = bi2; }
        }
        __syncthreads();
        if (tidb < 256) {
#pragma unroll
            for (int s = 0; s < 3; ++s) { const int j = SEL[tidb * 3 + s]; if (j >= 0) __hip_atomic_fetch_add(CNT + j, 1, __ATOMIC_RELAXED, __HIP_MEMORY_SCOPE_WORKGROUP); }
        }
        __syncthreads();
        if (wave == 0) {
            const int n = laneb < own ? CNT[laneb] : 0, ti = (n + 63) >> 6;
            int ninc = n, tinc = ti;
#pragma unroll
            for (int o = 1; o < 64; o <<= 1) { const int t1 = __shfl_up(ninc, o), t2 = __shfl_up(tinc, o); if (laneb >= o) { ninc += t1; tinc += t2; } }
            const int off = ninc - n, base = tinc - ti;
            if (laneb < own) OFFS[laneb] = off;
            for (int s = 0; s < ti; ++s) { ITEMS[4 * (base + s)] = laneb; ITEMS[4 * (base + s) + 1] = off + 64 * s; ITEMS[4 * (base + s) + 2] = (n - 64 * s) < 64 ? (n - 64 * s) : 64; }
            const int tot = __builtin_amdgcn_readlane(tinc, 63);
            if (laneb < 4) { ITEMS[4 * (tot + laneb)] = 32 + (3 - laneb); ITEMS[4 * (tot + laneb) + 1] = 0; ITEMS[4 * (tot + laneb) + 2] = 64; }
            if (laneb == 0) { CTL[0] = 4 + tot; CTL[1] = 0; }
        }
        __syncthreads();
        if (tidb < 256) {
#pragma unroll
            for (int s = 0; s < 3; ++s) { const int j = SEL[tidb * 3 + s]; if (j >= 0) { const int pos = __hip_atomic_fetch_add(FILL + j, 1, __ATOMIC_RELAXED, __HIP_MEMORY_SCOPE_WORKGROUP); LIST[OFFS[j] + pos] = tidb | (s << 8); } }
        }
        __syncthreads();
        const int nitems = CTL[0];
        for (;;) {
            int it = 0; if (lane == 0) it = __hip_atomic_fetch_add(CTL + 1, 1, __ATOMIC_RELAXED, __HIP_MEMORY_SCOPE_WORKGROUP);
            it = __builtin_amdgcn_readfirstlane(it);
            if (it >= nitems) break;
            const int code = ITEMS[4 * it], start = ITEMS[4 * it + 1], cnt = ITEMS[4 * it + 2];
            const bool ownit = code >= 32; const int qtA = 2 * (code - 32), qtB = qtA + 1, blk = ownit ? own : code;
            const bool two = cnt > 32;
            const bool validA = c32 < cnt, validB = 32 + c32 < cnt;
            const int entA = ownit ? ((qtA * 32 + c32) | (3 << 8)) : LIST[start + (validA ? c32 : 0)];
            const int entB = ownit ? ((qtB * 32 + c32) | (3 << 8)) : two ? LIST[start + 32 + (validB ? c32 : 0)] : entA;
            const int qrelA = entA & 255, qrelB = entB & 255;
            const int nkt = ownit ? qtB + 1 : 8;
            i64_t qfA[4], qfB[4];
            { const bf16* qp = Q + (rowq0 + qrelA) * DM + h * HD + 8 * hi; const bf16* qp2 = Q + (rowq0 + qrelB) * DM + h * HD + 8 * hi;
#pragma unroll
              for (int s = 0; s < 4; ++s) { qfA[s] = cvt_q8(*(const bf16x8*)(qp + 16 * s), C1); qfB[s] = cvt_q8(*(const bf16x8*)(qp2 + 16 * s), C1); } }
            const size_t bhb = ((size_t)b * NH + h) * NBLK + blk;
            const unsigned char* kp = K8 + ((bhb * 4 + 2 * hi) * 256 + pi32) * 16;
            const bf16* vp = Vt + ((bhb * 32 + hi) * 64 + c32) * 8;
            f32x16 oA0, oA1, oB0, oB1, scA, scB; float lsA = 0.f, lsB = 0.f;
#pragma unroll
            for (int r = 0; r < 16; ++r) { oA0[r] = 0.f; oA1[r] = 0.f; oB0[r] = 0.f; oB1[r] = 0.f; }
            i64_t kX[4], kY[4]; bf16x8 vX[2][2], vY[2][2];
#define ATT_LDK(dst, kt_) do { _Pragma("unroll") for (int sp = 0; sp < 2; ++sp) { const v4u w_ = *(const v4u*)(kp + (sp * 256 + 32 * (kt_)) * 16); \
                dst[2 * sp] = (i64_t)(((unsigned long long)w_.y << 32) | w_.x); dst[2 * sp + 1] = (i64_t)(((unsigned long long)w_.w << 32) | w_.z); } } while (0)
#define ATT_LDV(dst, kt_) do { _Pragma("unroll") for (int dt = 0; dt < 2; ++dt) _Pragma("unroll") for (int s2 = 0; s2 < 2; ++s2) dst[dt][s2] = *(const bf16x8*)(vp + ((4 * (kt_) + 2 * s2) * 64 + 32 * dt) * 8); } while (0)
#define ATT_S(dst, kf_, qf_) do { _Pragma("unroll") for (int r = 0; r < 16; ++r) dst[r] = -c0; _Pragma("unroll") for (int s = 0; s < 4; ++s) dst = __builtin_amdgcn_mfma_f32_32x32x16_fp8_fp8(kf_[s], qf_[s], dst, 0, 0, 0); } while (0)
#define ATT_SM(sc_, ls_, o0_, o1_, msk_, thr_, vf_) do { float p[16]; \
                _Pragma("unroll") for (int r = 0; r < 16; ++r) p[r] = __builtin_amdgcn_exp2f(sc_[r]); \
                if (msk_) { int him_ = 8 * hi; asm volatile("" : "+v"(him_)); _Pragma("unroll") for (int r = 0; r < 16; ++r) if (16 * (r >> 3) + him_ + (r & 7) > (thr_)) p[r] = 0.f; }        \
                { f32x2_t l2_ = {p[0], p[1]}; _Pragma("unroll") for (int r = 2; r < 16; r += 2) l2_ += (f32x2_t){p[r], p[r + 1]}; ls_ += l2_[0] + l2_[1]; } \
                const bf16x8 p0 = pack_p(p), p1 = pack_p(p + 8); \
                o0_ = __builtin_amdgcn_mfma_f32_32x32x16_bf16(vf_[0][0], p0, o0_, 0, 0, 0); o1_ = __builtin_amdgcn_mfma_f32_32x32x16_bf16(vf_[1][0], p0, o1_, 0, 0, 0); \
                o0_ = __builtin_amdgcn_mfma_f32_32x32x16_bf16(vf_[0][1], p1, o0_, 0, 0, 0); o1_ = __builtin_amdgcn_mfma_f32_32x32x16_bf16(vf_[1][1], p1, o1_, 0, 0, 0); } while (0)
#define ATT_STEP(kc, kn, vc, vn) do { \
                { const int k1_ = kt + 1 < nkt ? kt + 1 : nkt - 1; ATT_LDK(kn, k1_); ATT_LDV(vn, k1_); } \
                ATT_S(scA, kc, qfA); if (two) ATT_S(scB, kc, qfB); \
                ATT_SM(scA, lsA, oA0, oA1, (ownit && kt >= qtA), c32 - 32 * (kt - qtA), vc); \
                if (two) ATT_SM(scB, lsB, oB0, oB1, (ownit && kt == qtB), c32, vc); } while (0)
            ATT_LDK(kX, 0); ATT_LDV(vX, 0);
            for (int kt = 0;;) {
                ATT_STEP(kX, kY, vX, vY);
                if (++kt >= nkt) break;
                ATT_STEP(kY, kX, vY, vX);
                if (++kt >= nkt) break;
            }
#undef ATT_STEP
#undef ATT_LDK
#undef ATT_LDV
#undef ATT_S
#undef ATT_SM
            lsA += __shfl_xor(lsA, 32); lsB += __shfl_xor(lsB, 32);
            if (validA) { const int rk = entA >> 8; LAS unsigned char* sp = SLOT + (rk * 256 + qrelA) * 128;
                if (hi == 0) LACC[rk * 256 + qrelA] = lsA;
#pragma unroll
                for (int g4 = 0; g4 < 4; ++g4) { const int ch0 = 2 * g4 + hi;
                    *(LAS unsigned long long*)(sp + (((ch0) ^ (qrelA & 15)) << 3)) = (unsigned long long)pk2(oA0[4 * g4], oA0[4 * g4 + 1]) | ((unsigned long long)pk2(oA0[4 * g4 + 2], oA0[4 * g4 + 3]) << 32);
                    *(LAS unsigned long long*)(sp + (((ch0 + 8) ^ (qrelA & 15)) << 3)) = (unsigned long long)pk2(oA1[4 * g4], oA1[4 * g4 + 1]) | ((unsigned long long)pk2(oA1[4 * g4 + 2], oA1[4 * g4 + 3]) << 32); } }
            if (two && validB) { const int rk = entB >> 8; LAS unsigned char* sp = SLOT + (rk * 256 + qrelB) * 128;
                if (hi == 0) LACC[rk * 256 + qrelB] = lsB;
#pragma unroll
                for (int g4 = 0; g4 < 4; ++g4) { const int ch0 = 2 * g4 + hi;
                    *(LAS unsigned long long*)(sp + (((ch0) ^ (qrelB & 15)) << 3)) = (unsigned long long)pk2(oB0[4 * g4], oB0[4 * g4 + 1]) | ((unsigned long long)pk2(oB0[4 * g4 + 2], oB0[4 * g4 + 3]) << 32);
                    *(LAS unsigned long long*)(sp + (((ch0 + 8) ^ (qrelB & 15)) << 3)) = (unsigned long long)pk2(oB1[4 * g4], oB1[4 * g4 + 1]) | ((unsigned long long)pk2(oB1[4 * g4 + 2], oB1[4 * g4 + 3]) << 32); } }
        }
        __syncthreads();
        for (int idx = wave * 64 + pg8::fresh_lane(); idx < 256 * 8; idx += NTHR) { const int qq = idx >> 3, ck = idx & 7;
            const int s0_ = SEL[qq * 3], s1_ = SEL[qq * 3 + 1], s2_ = SEL[qq * 3 + 2];
            float lr[4]; unsigned long long w0[4], w1[4];
#pragma unroll
            for (int rk = 0; rk < 4; ++rk) { lr[rk] = LACC[rk * 256 + qq]; const LAS unsigned char* sp = SLOT + (rk * 256 + qq) * 128;
                w0[rk] = *(const LAS unsigned long long*)(sp + (((2 * ck) ^ (qq & 15)) << 3)); w1[rk] = *(const LAS unsigned long long*)(sp + (((2 * ck + 1) ^ (qq & 15)) << 3)); }
            float o[8], l = 0.f;
#pragma unroll
            for (int i = 0; i < 8; ++i) o[i] = 0.f;
#pragma unroll
            for (int rk = 0; rk < 4; ++rk) { const bool ok = rk == 3 ? true : (rk == 0 ? s0_ : rk == 1 ? s1_ : s2_) >= 0;
                const unsigned long long a0 = ok ? w0[rk] : 0ull, a1 = ok ? w1[rk] : 0ull; l += ok ? lr[rk] : 0.f;
                o[0] += __uint_as_float((unsigned)a0 << 16); o[1] += __uint_as_float((unsigned)a0 & 0xffff0000u); o[2] += __uint_as_float((unsigned)(a0 >> 32) << 16); o[3] += __uint_as_float((unsigned)(a0 >> 32) & 0xffff0000u);
                o[4] += __uint_as_float((unsigned)a1 << 16); o[5] += __uint_as_float((unsigned)a1 & 0xffff0000u); o[6] += __uint_as_float((unsigned)(a1 >> 32) << 16); o[7] += __uint_as_float((unsigned)(a1 >> 32) & 0xffff0000u); }
            const float il = 1.f / l;
            v4u w; w.x = pk2(o[0] * il, o[1] * il); w.y = pk2(o[2] * il, o[3] * il); w.z = pk2(o[4] * il, o[5] * il); w.w = pk2(o[6] * il, o[7] * il);
            *(v4u*)(AO + (rowq0 + qq) * DM + h * HD + 8 * ck) = w; }
        __syncthreads();
    }
}

#define XB_TMO      128
#define XB_XCNT(j)  (256  + 64 * (j))
#define XB_XSUB(j)  (1280 + 64 * (j))
#define XB_XGEN(j)  (2304 + 64 * (j))
#define XB_TOP      3328
#define XB_TOPGEN   3392
#define XCD_BAR_WORDS 3456
#define XB_SPIN_CAP (1u << 18)

__device__ __forceinline__ unsigned xb_ld(unsigned* p)              { return __hip_atomic_load(p, __ATOMIC_RELAXED, __HIP_MEMORY_SCOPE_AGENT); }
__device__ __forceinline__ unsigned xb_add(unsigned* p, unsigned v) { return __hip_atomic_fetch_add(p, v, __ATOMIC_RELAXED, __HIP_MEMORY_SCOPE_AGENT); }
__device__ __forceinline__ unsigned xb_xcc_id() { return (unsigned)__builtin_amdgcn_s_getreg((3 << 11) | 20) & 0xFu; }
#define XB_SPIN(cond, bar) do { unsigned _sp = 0; while (cond) { __builtin_amdgcn_s_sleep(1); \
    if ((++_sp & 255u) == 0u) { if (xb_ld(&(bar)[XB_TMO])) break; if (_sp > XB_SPIN_CAP) { atomicAdd(&(bar)[XB_TMO], 1u); break; } } } } while (0)

struct XcdBarrier {
    unsigned* bar; unsigned x; int w;
    volatile LAS unsigned* st;
};

__device__ __forceinline__ XcdBarrier xcd_barrier_post(unsigned* bar, volatile LAS unsigned* st, int wave) {
    XcdBarrier b; b.bar = bar; b.x = xb_xcc_id(); b.st = st; b.w = wave;
    if (wave == 0 && pg8::fresh_lane() == 0) (void)xb_add(&bar[XB_XCNT(b.x)], 1u);
    return b;
}
__device__ __forceinline__ void xcd_barrier_complete(unsigned* bar, unsigned x, unsigned& nloc, unsigned& nx) {
    const unsigned G = gridDim.x * gridDim.y * gridDim.z;
    unsigned sum, cnt, mine, sp = 0u;
    for (;;) {
        sum = 0u; cnt = 0u; mine = 0u;
#pragma unroll
        for (unsigned j = 0; j < 16; ++j) { const unsigned c = xb_ld(&bar[XB_XCNT(j)]); sum += c; cnt += (c > 0u) ? 1u : 0u; mine = (j == x) ? c : mine; }
        if (sum == G) break;
        __builtin_amdgcn_s_sleep(1);
        if ((++sp & 255u) == 0u) { if (xb_ld(&bar[XB_TMO])) break; if (sp > XB_SPIN_CAP) { atomicAdd(&bar[XB_TMO], 1u); break; } }
    }
    nloc = mine > 0u ? mine : 1u; nx = cnt > 0u ? cnt : 1u;
}

__device__ __forceinline__ void xcd_barrier(const XcdBarrier& b) {
    asm volatile("s_waitcnt vmcnt(0)" ::: "memory");
    __syncthreads();
    if (b.w == 0 && pg8::fresh_lane() == 0) {
        unsigned* bar = b.bar;
        __builtin_amdgcn_s_waitcnt(0);
        unsigned nloc = b.st[0], nx = b.st[1];
        if (nloc == 0u) { xcd_barrier_complete(bar, b.x, nloc, nx); b.st[0] = nloc; b.st[1] = nx; }
        const unsigned old = xb_add(&bar[XB_XSUB(b.x)], 1u);
        const unsigned gen = old / nloc;
        if (old + 1u == (gen + 1u) * nloc) {
            __builtin_amdgcn_fence(__ATOMIC_RELEASE, "agent");
            asm volatile("s_waitcnt vmcnt(0)" ::: "memory");
            const unsigned og = xb_add(&bar[XB_TOP], 1u);
            const unsigned tg = og / nx;
            if (og + 1u == (tg + 1u) * nx) xb_add(&bar[XB_TOPGEN], 1u);
            else XB_SPIN(xb_ld(&bar[XB_TOPGEN]) == tg, bar);
            __builtin_amdgcn_fence(__ATOMIC_ACQUIRE, "agent");
            xb_add(&bar[XB_XGEN(b.x)], 1u);
            asm volatile("s_waitcnt vmcnt(0)" ::: "memory");
        } else {
            XB_SPIN(xb_ld(&bar[XB_XGEN(b.x)]) == gen, bar);
            __builtin_amdgcn_fence(__ATOMIC_ACQUIRE, "agent");
            asm volatile("s_waitcnt vmcnt(0)" ::: "memory");
        }
    }
    __syncthreads();
}


template <int K> __device__ __forceinline__ void xcd_local_barrier(const XcdBarrier& b) {
    asm volatile("s_waitcnt vmcnt(0)" ::: "memory");
    __syncthreads();
    if (b.w == 0 && pg8::fresh_lane() == 0) {
        unsigned* cnt = b.bar + 3456 + 64 * b.x;
        __builtin_amdgcn_s_waitcnt(0);
        (void)xb_add(cnt, 1u);
        XB_SPIN(xb_ld(cnt) < 32u * (unsigned)(K + 1), b.bar);
        __builtin_amdgcn_fence(__ATOMIC_ACQUIRE, "agent");
        asm volatile("s_waitcnt vmcnt(0)" ::: "memory");
    }
    __syncthreads();
}

constexpr int LDS_BYTES = 163840;
__global__ void __launch_bounds__(NTHR, 2) mk_fwd(Args a) {
    cg::grid_group grid = cg::this_grid();
    extern __shared__ __attribute__((aligned(16))) unsigned char lds_raw[];
    LAS unsigned char* lds = (LAS unsigned char*)lds_raw;
    const int tid = threadIdx.x, lane = tid & 63, wave = __builtin_amdgcn_readfirstlane(tid >> 6);
    const int G = gridDim.x, gw = blockIdx.x * NWAVES + wave, NGW = G * NWAVES;
    unsigned char* ws = a.ws;
    const pg8::bf16_t* XB = (const pg8::bf16_t*)((const unsigned char*)a.out + OUT_XB);
    const pg8::bf16_t* WIN = (const pg8::bf16_t*)(ws + WS_WIN);
    float* R1 = (float*)(ws + WS_R1);

    volatile LAS unsigned* MISC = (volatile LAS unsigned*)(lds + 163584);
    if (tid < 64) MISC[tid] = 0u;
    __syncthreads();
    const XcdBarrier bar = xcd_barrier_post((unsigned*)(ws + WS_BAR), MISC + 8, wave);
    grid.sync();
#define GSYNC() xcd_barrier(bar)
#define T0() (wave == 0 && pg8::fresh_lane() == 0)
#define XLOCAL() (__builtin_amdgcn_readfirstlane((int)MISC[11]) != 0)
    p0_prologue(a, lds, gw, NGW, wave, lane);
    if (T0()) __hip_atomic_store((unsigned*)(ws + WS_BAR + 18432) + blockIdx.x, bar.x + 1u, __ATOMIC_RELAXED, __HIP_MEMORY_SCOPE_AGENT);
    GSYNC();
    if (T0()) { bool ok = (gridDim.x == 256) && (MISC[8] == 32u);
        for (int j = 0; j < 32 && ok; ++j) ok = __hip_atomic_load((unsigned*)(ws + WS_BAR + 18432) + (blockIdx.x & 7) + 8 * j, __ATOMIC_RELAXED, __HIP_MEMORY_SCOPE_AGENT) == bar.x + 1u;
        if (!ok) __hip_atomic_store((unsigned*)(ws + WS_BAR + 20480), 1u, __ATOMIC_RELAXED, __HIP_MEMORY_SCOPE_AGENT); }
    dt_phase(a, lds, 0, wave, 0);
    { pg8::Gemm g{WIN + (size_t)2048 * DM, XB, DM, M, DM}; pg8::StaticOrder S; S.init(DM, M, G, (int)blockIdx.x);
      ep::EpiVt E{(pg8::bf16_t*)(ws + WS_V), R1};
      pg8::gemm_phase<ep::EpiVt, pg8::StaticOrder, true, true>(lds, g, S, E, wave); }
    { pg8::Gemm g{XB, WIN, M, 2048, DM}; pg8::StaticOrder S; S.init(M, 2048, G, (int)blockIdx.x);
      ep::EpiQKV E{(pg8::bf16_t*)(ws + WS_Q), (pg8::bf16_t*)(ws + WS_K), (pg8::bf16_t*)(ws + WS_V), R1, a.in[I_GQ], a.in[I_GK], (float*)(ws + WS_KMEAN)};
      pg8::gemm_phase<ep::EpiQKV, pg8::StaticOrder, true, true>(lds, g, S, E, wave); }
    { pg8::Gemm g{XB, WIN + (size_t)3072 * DM, M, 3072, DM}; pg8::StaticOrder S; S.init(M, 3072, G, (int)blockIdx.x);
      ep::EpiAct<0> E{(pg8::bf16_t*)(ws + WS_XBC), 3072, R1, 0, 0};
      pg8::gemm_phase<ep::EpiAct<0>, pg8::StaticOrder, true, true>(lds, g, S, E, wave); }
    GSYNC();
    if (T0()) MISC[11] = __hip_atomic_load((unsigned*)(ws + WS_BAR + 20480), __ATOMIC_RELAXED, __HIP_MEMORY_SCOPE_AGENT) == 0u ? 1u : 0u;
    __syncthreads();
    attn_mfma(a, lds, 0, wave, 0, (bf16*)(ws + WS_Q), XLOCAL() && gridDim.x == 256, (unsigned*)(ws + WS_BAR) + 5632 + 64 * (blockIdx.x & 7));
    ssd_s1(a, lds, 0, wave, 0);
    GSYNC();
    ssd_s2(a, wave * 64 + pg8::fresh_lane());
    { pg8::Gemm g{XB, WIN + (size_t)6144 * DM, M, 2048, DM}; pg8::StaticOrder S; S.init(M, 2048, G, (int)blockIdx.x);
      ep::EpiAct<1> E{(pg8::bf16_t*)(ws + WS_Z), 2048, R1, 0, 0};
      pg8::gemm_phase<ep::EpiAct<1>, pg8::StaticOrder, true, true>(lds, g, S, E, wave); }
    GSYNC();
    ssd_s3(a, lds, 0, wave, 0);
    GSYNC();
    { pg8::Gemm g{XB, WIN + (size_t)8192 * DM, M, DM, DM}; pg8::StaticOrder S; S.init(M, DM, G, (int)blockIdx.x);
      ep::EpiAct<2> E{(pg8::bf16_t*)(ws + WS_GA), 1024, R1, 0, 0};
      pg8::gemm_phase<ep::EpiAct<2>, pg8::StaticOrder, true, true>(lds, g, S, E, wave); }
    { pg8::Gemm g{XB, WIN + (size_t)9216 * DM, M, DM, DM}; pg8::StaticOrder S; S.init(M, DM, G, (int)blockIdx.x);
      ep::EpiAct<2> E{(pg8::bf16_t*)(ws + WS_GB), 1024, R1, 0, 0};
      pg8::gemm_phase<ep::EpiAct<2>, pg8::StaticOrder, true, true>(lds, g, S, E, wave); }
    { pg8::Gemm g{(const pg8::bf16_t*)(ws + WS_Q), (const pg8::bf16_t*)(ws + WS_WOA), M, DM, DM}; pg8::StaticOrder S; S.init(M, DM, G, (int)blockIdx.x);
      ep::EpiGate1 E{(pg8::bf16_t*)(ws + WS_GA)};
      pg8::gemm_phase<ep::EpiGate1, pg8::StaticOrder, true, true>(lds, g, S, E, wave); }
    { pg8::Gemm g{(const pg8::bf16_t*)(ws + WS_Z), (const pg8::bf16_t*)(ws + WS_WOS), M, DM, SSM_IN}; pg8::StaticOrder S; S.init(M, DM, G, (int)blockIdx.x);
      ep::EpiGate2 E{(pg8::bf16_t*)(ws + WS_GA), (const pg8::bf16_t*)(ws + WS_GB)};
      pg8::gemm_phase<ep::EpiGate2, pg8::StaticOrder, true, true>(lds, g, S, E, wave); }
    if (XLOCAL()) xcd_local_barrier<0>(bar); else GSYNC();
    { pg8::Gemm g{(const pg8::bf16_t*)(ws + WS_GA), (const pg8::bf16_t*)(ws + WS_WOUT), M, DM, DM}; pg8::StaticOrder S; S.init(M, DM, G, (int)blockIdx.x);
      ep::EpiRes<false> E{a.in[I_X], (pg8::bf16_t*)(ws + WS_X1B), (float*)(ws + WS_R2P)};
      pg8::gemm_phase<ep::EpiRes<false>, pg8::StaticOrder, true, true>(lds, g, S, E, wave); }
    GSYNC();
    { pg8::Gemm g{(const pg8::bf16_t*)(ws + WS_X1B), (const pg8::bf16_t*)(ws + WS_WGU), M, 2 * DFF, DM}; pg8::StaticOrder S; S.init(M, 2 * DFF, G, (int)blockIdx.x);
      ep::EpiSwiGLU E{(pg8::bf16_t*)(ws + WS_ACT), (const float*)(ws + WS_R2P)};
      pg8::gemm_phase<ep::EpiSwiGLU, pg8::StaticOrder, true, true>(lds, g, S, E, wave); }
    { pg8::Gemm g{(const pg8::bf16_t*)(ws + WS_PB), (const pg8::bf16_t*)(ws + WS_WPP), M, DM, PLE}; pg8::StaticOrder S;
      if (G == 256) S.init(M, DM, 128, (int)blockIdx.x >= 128 ? (int)blockIdx.x - 128 : 4096); else S.init(M, DM, G, (int)blockIdx.x);
      ep::EpiAct<0> E{(pg8::bf16_t*)(ws + WS_PP), 1024, nullptr, 0, 0};
      pg8::gemm_phase<ep::EpiAct<0>, pg8::StaticOrder, true, true>(lds, g, S, E, wave); }
    if (XLOCAL()) xcd_local_barrier<1>(bar); else GSYNC();
    { pg8::Gemm g{(const pg8::bf16_t*)(ws + WS_ACT), (const pg8::bf16_t*)(ws + WS_WDN), M, DM, DFF}; pg8::StaticOrder S; S.init(M, DM, G, (int)blockIdx.x);
      ep::EpiRes<true> E{(const void*)(ws + WS_X1B), (pg8::bf16_t*)(ws + WS_X2B), (float*)(ws + WS_R3P)};
      pg8::gemm_phase<ep::EpiRes<true>, pg8::StaticOrder, true, true>(lds, g, S, E, wave); }
    if (XLOCAL()) xcd_local_barrier<2>(bar); else GSYNC();
    { pg8::Gemm g{(const pg8::bf16_t*)(ws + WS_X2B), (const pg8::bf16_t*)(ws + WS_WPG), M, DM, DM}; pg8::StaticOrder S; S.init(M, DM, G, (int)blockIdx.x);
      ep::EpiPle E{a.out, (const pg8::bf16_t*)(ws + WS_X2B), (const pg8::bf16_t*)(ws + WS_PP), (const float*)(ws + WS_R3P)};
      pg8::gemm_phase<ep::EpiPle, pg8::StaticOrder, true, true>(lds, g, S, E, wave); }
}

extern "C" void kernel_launch(void* const* d_in, const int* in_sizes, int n_in, void* d_out, int out_size, void* d_ws, size_t ws_size, hipStream_t stream) {
    static int grid = 0;
    if (grid == 0) {
        if (n_in != 21 || out_size != M * DM || ws_size < WS_END) { fprintf(stderr, "kernel_launch: unexpected problem (n_in %d out %d ws %zu); nothing launched\n", n_in, out_size, ws_size); grid = -1; return; }
        int dev = 0, cus = 0, per_cu = 0;
        if (hipGetDevice(&dev) != hipSuccess || hipDeviceGetAttribute(&cus, hipDeviceAttributeMultiprocessorCount, dev) != hipSuccess) { grid = -1; return; }
        if (hipFuncSetAttribute((const void*)mk_fwd, hipFuncAttributeMaxDynamicSharedMemorySize, LDS_BYTES) != hipSuccess) { fprintf(stderr, "kernel_launch: hipFuncSetAttribute failed\n"); grid = -1; return; }
        if (hipOccupancyMaxActiveBlocksPerMultiprocessor(&per_cu, (const void*)mk_fwd, NTHR, LDS_BYTES) != hipSuccess || per_cu < 1) { fprintf(stderr, "kernel_launch: occupancy query says %d blocks/CU\n", per_cu); grid = -1; return; }
        grid = cus;
        (void)hipGetLastError();
    }
    if (grid < 0) return;
    if (hipMemsetAsync((char*)d_ws + WS_BAR, 0, BAR_BYTES, stream) != hipSuccess) { fprintf(stderr, "kernel_launch: memset failed\n"); return; }
    Args a{};
    for (int i = 0; i < 21; ++i) a.in[i] = (const float*)d_in[i];
    a.out = (float*)d_out; a.ws = (unsigned char*)d_ws;
    void* args[] = {&a};
    hipError_t e = hipLaunchCooperativeKernel((const void*)mk_fwd, dim3(grid), dim3(NTHR), args, LDS_BYTES, stream);
    if (e != hipSuccess) fprintf(stderr, "cooperative launch failed: %s (grid %d)\n", hipGetErrorString(e), grid);
}
```

```cpp
#include <hip/hip_runtime.h>
#include <hip/hip_cooperative_groups.h>
#include <cstdio>
#include <cstdint>
namespace cg = cooperative_groups;
namespace pg8 {
#define PG8_LAS __attribute__((address_space(3)))
typedef unsigned short bf16_t;
typedef short bf16x8 __attribute__((ext_vector_type(8)));
typedef float f32x4 __attribute__((ext_vector_type(4)));
typedef unsigned u32x4 __attribute__((ext_vector_type(4)));
constexpr int BM = 256, BK = 64, HALF = 128, HTB = HALF * BK * 2  , STAGE_BYTES = 8 * HTB, NXCD = 8, WGM = 4;

__host__ __device__ __forceinline__ int lds_byte(int r, int c) { const int st = (r >> 4) * 2 + (c >> 5), rr = r & 15, cc = c & 31, ob = rr * 64 + cc * 2; return st * 1024 + (ob ^ (((ob >> 9) & 1) << 5)); }
__host__ __device__ __forceinline__ void stage_rc(int b, int& R, int& C) { const int st = b / 1024, sb = b % 1024, swz = sb ^ (((sb >> 9) & 1) << 5); R = (st >> 1) * 16 + swz / 64; C = (st & 1) * 32 + (swz % 64) / 2; }
__host__ __device__ __forceinline__ int perm32(int rho) { const int n = rho >> 4, i = rho & 15; return 8 * (i >> 2) + 4 * n + (i & 3); }

struct Unit { int pm, pn; };
struct Gemm { const bf16_t* A; const bf16_t* Bt; int M, N, K; };

struct StaticOrder {
    int nM, nN, nwg, G, c;
    __host__ __device__ void init(int M, int N, int G_, int c_) { nM = M / BM; nN = N / BM; nwg = nM * nN; G = G_; c = c_; }
    __host__ __device__ bool next(int i, Unit& u) const {
        const long L = (long)i * G + c; if (L >= nwg) return false;
        int wgid = (int)L; { const int q = nwg / NXCD, r = nwg % NXCD, xcd = wgid % NXCD, off = wgid / NXCD; wgid = (xcd < r ? xcd * (q + 1) : r * (q + 1) + (xcd - r) * q) + off; }
        const int nig = WGM * nN, gid = wgid / nig, fm = gid * WGM, gsz = (nM - fm) < WGM ? (nM - fm) : WGM;
        u.pm = fm + ((wgid % nig) % gsz); u.pn = (wgid % nig) / gsz; return true;
    }
    __device__ __forceinline__ void a_ready(const Unit&) const {}
    __device__ __forceinline__ void done(const Unit&) const {}
};

__device__ __forceinline__ unsigned cvt_pk_bf16(float lo, float hi) { unsigned r; asm volatile("v_cvt_pk_bf16_f32 %0, %1, %2" : "=v"(r) : "v"(lo), "v"(hi)); return r; }
typedef float f32x2 __attribute__((ext_vector_type(2)));
__device__ __forceinline__ int fresh_lane() { int l; asm volatile("v_mbcnt_lo_u32_b32 %0, -1, 0\n\tv_mbcnt_hi_u32_b32 %0, -1, %0" : "=v"(l)); return l; }
template <class Epi, class Sched, bool ALIGN_EPI = false, bool SP2 = false>
__device__ __forceinline__ void gemm_phase(PG8_LAS unsigned char* lds, const Gemm g, const Sched& S, const Epi& E, int wave_s) {
    const int lane = fresh_lane(), tid = wave_s * 64 + lane, wid = wave_s, wr = wid >> 2, wc = wid & 3, fr = lane & 15, fq = lane >> 4;
    const int K = g.K, nt = K / BK;
    unsigned voffA[2], voffB[2];
#pragma unroll
    for (int i = 0; i < 2; ++i) { int R, C; stage_rc(tid * 16 + i * 8192, R, C); const int Rb = Epi::PERM ? ((R & ~31) + perm32(R & 31)) : R;
        voffA[i] = (unsigned)(R * K + C) * 2u; voffB[i] = (unsigned)(Rb * K + C) * 2u; }
    const size_t kstep = (size_t)(BK * 2);
    const size_t hstep = (size_t)HALF * K * 2;
    const size_t tstep = 2 * hstep;
    const unsigned ldsw = (unsigned)wid * 1024u;
    const int aoff = lds_byte(wr * 64 + fr, fq * 8), boff = lds_byte(wc * 32 + fr, fq * 8);
#define PG8_SA(b, h) (((b) * 2 + (h)) * HTB)
#define PG8_SB(b, h) ((4 + (b) * 2 + (h)) * HTB)
#define PG8_STAGE(bufoff, gbase, voff) do { _Pragma("unroll") for (int _i = 0; _i < 2; ++_i) \
        __builtin_amdgcn_global_load_lds((const unsigned*)((const char*)(gbase) + (voff)[_i]), (PG8_LAS unsigned*)(lds + (bufoff) + ldsw + _i * 8192), 16, 0, 0); } while (0)
#define PG8_LDA(dst, b, h) do { _Pragma("unroll") for (int m = 0; m < 4; ++m) _Pragma("unroll") for (int k = 0; k < 2; ++k) dst[m][k] = *(const PG8_LAS bf16x8*)(lds + PG8_SA(b, h) + aoff + m * 2048 + k * 1024); } while (0)
#define PG8_LDB(dst, b, h) do { _Pragma("unroll") for (int n = 0; n < 2; ++n) _Pragma("unroll") for (int k = 0; k < 2; ++k) dst[n][k] = *(const PG8_LAS bf16x8*)(lds + PG8_SB(b, h) + boff + n * 2048 + k * 1024); } while (0)
#define PG8_MMA(ai, bj, At, Bt) do { __builtin_amdgcn_s_setprio(1); _Pragma("unroll") for (int m = 0; m < 4; ++m) _Pragma("unroll") for (int n = 0; n < 2; ++n) _Pragma("unroll") for (int k = 0; k < 2; ++k) \
        acc[ai][bj][m][n] = __builtin_amdgcn_mfma_f32_16x16x32_bf16(Bt[n][k], At[m][k], acc[ai][bj][m][n], 0, 0, 0); __builtin_amdgcn_s_setprio(0); } while (0)
#define PG8_WAIT_V(n) asm volatile("s_waitcnt vmcnt(" #n ")" ::: "memory")
#define PG8_WAIT_L(n) asm volatile("s_waitcnt lgkmcnt(" #n ")" ::: "memory")
#define PG8_BAR __builtin_amdgcn_s_barrier()
#define PG8_SCHED __builtin_amdgcn_sched_barrier(0)
    Unit cur, nxt; int ui = 0;
    if (!S.next(0, cur)) return;
    f32x4 acc[2][2][4][2];
#pragma unroll
    for (int a = 0; a < 2; ++a)
#pragma unroll
        for (int b = 0; b < 2; ++b)
#pragma unroll
            for (int m = 0; m < 4; ++m)
#pragma unroll
                for (int n = 0; n < 2; ++n) acc[a][b][m][n] = (f32x4){0.f, 0.f, 0.f, 0.f};
    bf16x8 At[4][2], B0[2][2], B1[2][2];
    const char* cA = (const char*)g.A + (size_t)cur.pm * tstep; const char* cB = (const char*)g.Bt + (size_t)cur.pn * tstep;
    S.a_ready(cur);
    if constexpr (SP2) {
        PG8_STAGE(PG8_SB(0, 0), cB, voffB); PG8_STAGE(PG8_SB(0, 1), cB + hstep, voffB); PG8_STAGE(PG8_SA(0, 0), cA, voffA); PG8_STAGE(PG8_SA(0, 1), cA + hstep, voffA);
        if (wr == 1) PG8_BAR;
        PG8_WAIT_V(2); PG8_BAR;
        PG8_STAGE(PG8_SB(1, 0), cB + kstep, voffB); PG8_STAGE(PG8_SA(1, 0), cA + kstep, voffA); PG8_STAGE(PG8_SB(1, 1), cB + hstep + kstep, voffB);
        PG8_WAIT_V(6); PG8_BAR;
    } else {
        PG8_STAGE(PG8_SB(0, 0), cB, voffB); PG8_STAGE(PG8_SA(0, 0), cA, voffA); PG8_STAGE(PG8_SB(0, 1), cB + hstep, voffB); PG8_STAGE(PG8_SA(0, 1), cA + hstep, voffA);
        if (wr == 1) PG8_BAR;
        PG8_WAIT_V(4); PG8_BAR;
        PG8_STAGE(PG8_SB(1, 0), cB + kstep, voffB); PG8_STAGE(PG8_SA(1, 0), cA + kstep, voffA); PG8_STAGE(PG8_SB(1, 1), cB + hstep + kstep, voffB);
        PG8_WAIT_V(6); PG8_BAR;
    }
    for (;;) {
        const bool has_next = S.next(ui + 1, nxt);
        const char* nA = has_next ? (const char*)g.A + (size_t)nxt.pm * tstep : cA; const char* nB = has_next ? (const char*)g.Bt + (size_t)nxt.pn * tstep : cB;
        for (int t = 0; t < nt; t += 2) {
            const bool last = (t == nt - 2);
            const char* a1 = cA + (size_t)(t + 1) * kstep;
            const char* a2 = last ? nA : cA + (size_t)(t + 2) * kstep; const char* b2 = last ? nB : cB + (size_t)(t + 2) * kstep;
            const char* a3 = a2 + kstep; const char* b3 = b2 + kstep;
            if (last && has_next) S.a_ready(nxt);
            if constexpr (SP2) {
            PG8_LDB(B0, 0, 0); PG8_LDB(B1, 0, 1); PG8_SCHED; PG8_LDA(At, 0, 0); PG8_STAGE(PG8_SA(1, 1), a1 + hstep, voffA);
            PG8_WAIT_V(8); PG8_WAIT_L(0); PG8_BAR; PG8_MMA(0, 0, At, B0); PG8_MMA(0, 1, At, B1); PG8_BAR; PG8_SCHED;
            PG8_LDA(At, 0, 1); PG8_STAGE(PG8_SB(0, 0), b2, voffB); PG8_STAGE(PG8_SB(0, 1), b2 + hstep, voffB); PG8_STAGE(PG8_SA(0, 0), a2, voffA);
            PG8_WAIT_V(8); PG8_WAIT_L(0); PG8_BAR; PG8_MMA(1, 0, At, B0); PG8_MMA(1, 1, At, B1); PG8_BAR; PG8_SCHED;
            PG8_LDB(B0, 1, 0); PG8_LDB(B1, 1, 1); PG8_SCHED; PG8_LDA(At, 1, 0); PG8_STAGE(PG8_SA(0, 1), a2 + hstep, voffA);
            PG8_WAIT_V(8); PG8_WAIT_L(0); PG8_BAR; PG8_MMA(0, 0, At, B0); PG8_MMA(0, 1, At, B1); PG8_BAR; PG8_SCHED;
            PG8_LDA(At, 1, 1); PG8_STAGE(PG8_SB(1, 0), b3, voffB); PG8_STAGE(PG8_SB(1, 1), b3 + hstep, voffB); PG8_STAGE(PG8_SA(1, 0), a3, voffA);
            PG8_WAIT_V(8); PG8_WAIT_L(0); PG8_BAR; PG8_MMA(1, 0, At, B0); PG8_MMA(1, 1, At, B1); PG8_BAR; PG8_SCHED;
            } else {
            PG8_LDB(B0, 0, 0); PG8_SCHED; PG8_LDA(At, 0, 0); PG8_STAGE(PG8_SA(1, 1), a1 + hstep, voffA);
            PG8_WAIT_L(8); PG8_BAR; PG8_WAIT_L(0); PG8_MMA(0, 0, At, B0); PG8_BAR; PG8_SCHED;
            PG8_LDB(B1, 0, 1); PG8_STAGE(PG8_SB(0, 0), b2, voffB);
            PG8_BAR; PG8_WAIT_L(0); PG8_MMA(0, 1, At, B1); PG8_BAR;
            PG8_LDA(At, 0, 1); PG8_STAGE(PG8_SA(0, 0), a2, voffA);
            PG8_BAR; PG8_WAIT_L(0); PG8_MMA(1, 0, At, B0); PG8_BAR; PG8_SCHED;
            PG8_STAGE(PG8_SB(0, 1), b2 + hstep, voffB);
            PG8_WAIT_V(6); PG8_BAR; PG8_MMA(1, 1, At, B1); PG8_BAR;
            PG8_LDB(B0, 1, 0); PG8_SCHED; PG8_LDA(At, 1, 0); PG8_STAGE(PG8_SA(0, 1), a2 + hstep, voffA);
            PG8_WAIT_L(8); PG8_BAR; PG8_WAIT_L(0); PG8_MMA(0, 0, At, B0); PG8_BAR; PG8_SCHED;
            PG8_LDB(B1, 1, 1); PG8_STAGE(PG8_SB(1, 0), b3, voffB);
            PG8_BAR; PG8_WAIT_L(0); PG8_MMA(0, 1, At, B1); PG8_BAR;
            PG8_LDA(At, 1, 1); PG8_STAGE(PG8_SA(1, 0), a3, voffA);
            PG8_BAR; PG8_WAIT_L(0); PG8_MMA(1, 0, At, B0); PG8_BAR; PG8_SCHED;
            PG8_STAGE(PG8_SB(1, 1), b3 + hstep, voffB);
            PG8_WAIT_V(6); PG8_BAR; PG8_MMA(1, 1, At, B1); PG8_BAR;
            }
        }
        if constexpr (ALIGN_EPI) { if (wr == 0) PG8_BAR; }
        if constexpr (!Epi::AFTER_DRAIN) { E(acc, cur, wr, wc, fr, fq); S.done(cur); }
        if (!has_next) break;
#pragma unroll
        for (int a = 0; a < 2; ++a)
#pragma unroll
            for (int b = 0; b < 2; ++b)
#pragma unroll
                for (int m = 0; m < 4; ++m)
#pragma unroll
                    for (int n = 0; n < 2; ++n) acc[a][b][m][n] = (f32x4){0.f, 0.f, 0.f, 0.f};
        cur = nxt; cA = nA; cB = nB; ++ui;
        if constexpr (ALIGN_EPI) { if (wr == 1) PG8_BAR; }
    }
    PG8_WAIT_V(0);
    if constexpr (!ALIGN_EPI) { if (wr == 0) PG8_BAR; }
    PG8_BAR;
    if constexpr (Epi::AFTER_DRAIN) { E.fused(acc, cur, wr, wc, fr, fq, lds, wid, lane); S.done(cur); }
#undef PG8_SA
#undef PG8_SB
#undef PG8_STAGE
#undef PG8_LDA
#undef PG8_LDB
#undef PG8_MMA
#undef PG8_WAIT_V
#undef PG8_WAIT_L
#undef PG8_BAR
#undef PG8_SCHED
}
}

constexpr int BATCH = 2, SEQ = 8192, DM = 1024, M = BATCH * SEQ;
constexpr int NH = 16, HD = 64, BLK = 256, NBLK = SEQ / BLK;
constexpr int SSM_IN = 2048, SSM_H = 32, SSM_P = 64, SSM_G = 4, SSM_N = 128, CONVD = 3072;
constexpr int DFF = 2816, PLE = 256, IN_DIM = 10272;
constexpr float EPS = 1e-6f;
constexpr int NWAVES = 8, NTHR = 512;

#define GAS __attribute__((address_space(1)))
#define LAS __attribute__((address_space(3)))
typedef unsigned short bf16;
typedef unsigned v4u __attribute__((ext_vector_type(4)));
typedef float f32x4 __attribute__((ext_vector_type(4)));
typedef short bf16x8 __attribute__((ext_vector_type(8)));
#define LDS_WAIT() asm volatile("s_waitcnt lgkmcnt(0)" ::: "memory")

__device__ __forceinline__ float bf2f(unsigned short b) { return __uint_as_float(((unsigned)b) << 16); }
__device__ __forceinline__ unsigned f2bf(float f) { unsigned u = __float_as_uint(f); return (u + 0x7fffu + ((u >> 16) & 1u)) >> 16; }
typedef __bf16 bf16x2_t __attribute__((ext_vector_type(2))); typedef float f32x2_t __attribute__((ext_vector_type(2)));
__device__ __forceinline__ unsigned pk2(float lo, float hi) { f32x2_t v = {lo, hi}; bf16x2_t b = __builtin_convertvector(v, bf16x2_t); return __builtin_bit_cast(unsigned, b); }
__device__ __forceinline__ float wave_sum(float v) {
#pragma unroll
    for (int o = 1; o < 64; o <<= 1) v += __shfl_xor(v, o);
    return v;
}
__device__ __forceinline__ float sigm(float x) { return __builtin_amdgcn_rcpf(1.f + __builtin_amdgcn_exp2f(x * -1.4426950408889634f)); }
__device__ __forceinline__ float siluf(float x) { return x * sigm(x); }

constexpr size_t MiB = 1u << 20;
constexpr size_t WS_R1 = 0, WS_KMEAN = 254 * MiB  , WS_R2P = 1 * MiB, WS_R3P = 2 * MiB, WS_DT = 3 * MiB;
constexpr size_t WS_BAR = 640 * 1024, BAR_BYTES = 32768;
constexpr size_t WS_WIN = 5 * MiB;
constexpr size_t WS_WOA = 26 * MiB, WS_WOS = 28 * MiB;
constexpr size_t WS_Q = 32 * MiB, WS_K = 64 * MiB, WS_V = 96 * MiB;
constexpr size_t WS_Z = 64 * MiB;
constexpr size_t WS_XBC = 128 * MiB;
constexpr size_t WS_WOUT = 224 * MiB, WS_WGU = 226 * MiB, WS_WDN = 237 * MiB, WS_WPG = 243 * MiB, WS_WPP = 245 * MiB, WS_PB = 246 * MiB;
constexpr size_t WS_GA = 128 * MiB, WS_GB = 160 * MiB;
constexpr size_t WS_X1B = 192 * MiB;
constexpr size_t WS_ACT = 32 * MiB, WS_X2B = 160 * MiB, WS_PP = 128 * MiB;
constexpr size_t WS_TAIL = 254 * MiB + 512 * 1024;
constexpr size_t WS_END = 256 * MiB;
constexpr size_t OUT_XB = 0;

namespace ep {
using pg8::bf16_t; using pg8::Unit; using pg8::u32x4; using pg8::cvt_pk_bf16;
__device__ __forceinline__ u32x4 pack8(f32x4 a, f32x4 b) { u32x4 w; w.x = pk2(a[0], a[1]); w.y = pk2(a[2], a[3]); w.z = pk2(b[0], b[1]); w.w = pk2(b[2], b[3]); return w; }
__device__ __forceinline__ uint2 pack8_fp8(f32x4 a, f32x4 b) { int w0 = 0, w1 = 0;
    w0 = __builtin_amdgcn_cvt_pk_fp8_f32(a[0], a[1], w0, false); w0 = __builtin_amdgcn_cvt_pk_fp8_f32(a[2], a[3], w0, true);
    w1 = __builtin_amdgcn_cvt_pk_fp8_f32(b[0], b[1], w1, false); w1 = __builtin_amdgcn_cvt_pk_fp8_f32(b[2], b[3], w1, true); return make_uint2((unsigned)w0, (unsigned)w1); }
__device__ __forceinline__ void unpack8(u32x4 w, f32x4& a, f32x4& b) {
    a[0] = __uint_as_float(w.x << 16); a[1] = __uint_as_float(w.x & 0xffff0000u); a[2] = __uint_as_float(w.y << 16); a[3] = __uint_as_float(w.y & 0xffff0000u);
    b[0] = __uint_as_float(w.z << 16); b[1] = __uint_as_float(w.z & 0xffff0000u); b[2] = __uint_as_float(w.w << 16); b[3] = __uint_as_float(w.w & 0xffff0000u); }
__device__ __forceinline__ float dot4(f32x4 v) { return (v[0] * v[0] + v[1] * v[1]) + (v[2] * v[2] + v[3] * v[3]); }

template <int ACT> struct EpiAct {
    static constexpr bool PERM = true, AFTER_DRAIN = false;
    bf16_t* O; int ldc; const float* rs; int split_tiles; size_t split_stride;
    __device__ __forceinline__ void operator()(const f32x4 (&acc)[2][2][4][2], const Unit& u, int wr, int wc, int fr, int fq) const {
        int pn = u.pn; bf16_t* base = O; if (split_tiles) { const int t = pn / split_tiles; base += (size_t)t * split_stride; pn -= t * split_tiles; }
        const int row0 = u.pm * 256 + wr * 64 + fr, col0 = pn * 256 + wc * 32 + 8 * fq;
        float sv[8];
#pragma unroll
        for (int i = 0; i < 8; ++i) sv[i] = rs ? rs[row0 + (i >> 2) * 128 + (i & 3) * 16] : 1.f;
        asm volatile("" ::: "memory");
#pragma unroll
        for (int ai = 0; ai < 2; ++ai)
#pragma unroll
            for (int m = 0; m < 4; ++m) { const int row = row0 + ai * 128 + m * 16; const float s = sv[ai * 4 + m]; bf16_t* rowp = base + (size_t)row * ldc + col0;
#pragma unroll
                for (int bj = 0; bj < 2; ++bj) { f32x4 v0 = acc[ai][bj][m][0] * s, v1 = acc[ai][bj][m][1] * s;
                    if (ACT == 1) { v0 = (f32x4){siluf(v0[0]), siluf(v0[1]), siluf(v0[2]), siluf(v0[3])}; v1 = (f32x4){siluf(v1[0]), siluf(v1[1]), siluf(v1[2]), siluf(v1[3])}; }
                    if (ACT == 2) { v0 = (f32x4){sigm(v0[0]), sigm(v0[1]), sigm(v0[2]), sigm(v0[3])}; v1 = (f32x4){sigm(v1[0]), sigm(v1[1]), sigm(v1[2]), sigm(v1[3])}; }
                    *(u32x4*)(rowp + bj * 128) = pack8(v0, v1); } }
    }
};
struct EpiQKV {
    static constexpr bool PERM = true, AFTER_DRAIN = false;
    bf16_t *Q, *K, *V; const float* r1; const float* gq; const float* gk; float* KS;
    __device__ __forceinline__ void operator()(const f32x4 (&acc)[2][2][4][2], const Unit& u, int wr, int wc, int fr, int fq) const {
        const int sect = u.pn >> 2, pt = u.pn & 3; const int row0 = u.pm * 256 + wr * 64 + fr;
        {
            const float* g = sect == 0 ? gq : gk; bf16_t* O = sect == 0 ? Q : K;
            const int head = pt * 4 + wc, col0 = head * 64 + 8 * fq;
            f32x4 cs[2][2];
#pragma unroll
            for (int bj = 0; bj < 2; ++bj) { cs[bj][0] = (f32x4){0.f, 0.f, 0.f, 0.f}; cs[bj][1] = (f32x4){0.f, 0.f, 0.f, 0.f}; }
            float sv[8]; f32x4 gv[2][2];
#pragma unroll
            for (int i = 0; i < 8; ++i) sv[i] = r1[row0 + (i >> 2) * 128 + (i & 3) * 16];
#pragma unroll
            for (int bj = 0; bj < 2; ++bj) { gv[bj][0] = *(const f32x4*)(g + 32 * bj + 8 * fq); gv[bj][1] = *(const f32x4*)(g + 32 * bj + 8 * fq + 4); }
            asm volatile("" ::: "memory");
            float ss8[8];
#pragma unroll
            for (int i = 0; i < 8; ++i) { float ss = 0.f;
#pragma unroll
                for (int bj = 0; bj < 2; ++bj)
#pragma unroll
                    for (int n = 0; n < 2; ++n) ss += dot4(acc[i >> 2][bj][i & 3][n]);
                ss8[i] = ss; }
#pragma unroll
            for (int i = 0; i < 8; ++i) ss8[i] += __shfl_xor(ss8[i], 16);
#pragma unroll
            for (int i = 0; i < 8; ++i) ss8[i] += __shfl_xor(ss8[i], 32);
#pragma unroll
            for (int ai = 0; ai < 2; ++ai)
#pragma unroll
                for (int m = 0; m < 4; ++m) { const int row = row0 + ai * 128 + m * 16; const float s = sv[ai * 4 + m];
                    const float ss = ss8[ai * 4 + m];
                    const float scl = s * rsqrtf(ss * s * s * (1.f / 64.f) + EPS);
                    bf16_t* rowq = O + (size_t)row * 1024 + col0;
                    unsigned char* rowk = (unsigned char*)O + (((((size_t)(u.pm >> 5) * NH + head) * NBLK + (u.pm & 31)) * 4 + 2 * (fq & 1)) * 256 + (size_t)(row & 255)) * 16 + 8 * (fq >> 1);
#pragma unroll
                    for (int bj = 0; bj < 2; ++bj) { const f32x4 g0 = gv[bj][0], g1 = gv[bj][1];
                        const f32x4 v0 = acc[ai][bj][m][0] * scl * g0, v1 = acc[ai][bj][m][1] * scl * g1;
                        cs[bj][0] += v0; cs[bj][1] += v1;
                        if (sect == 0) *(u32x4*)(rowq + bj * 32) = pack8(v0, v1); else *(uint2*)(rowk + bj * 4096) = pack8_fp8(v0, v1); }
                    asm volatile("" ::: "memory"); }
            if (sect == 1) {
#pragma unroll
                for (int o = 1; o < 16; o <<= 1)
#pragma unroll
                    for (int bj = 0; bj < 2; ++bj)
#pragma unroll
                        for (int n = 0; n < 2; ++n)
#pragma unroll
                            for (int j = 0; j < 4; ++j) cs[bj][n][j] += __shfl_xor(cs[bj][n][j], o);
                if (fr == 0) { float* kp = KS + ((((size_t)(u.pm >> 5) * NH + head) * NBLK + (u.pm & 31)) * 2 + wr) * 64 + 8 * fq;
#pragma unroll
                    for (int bj = 0; bj < 2; ++bj) { *(f32x4*)(kp + 32 * bj) = cs[bj][0]; *(f32x4*)(kp + 32 * bj + 4) = cs[bj][1]; } }
            }
        }
    }
};
struct EpiVt {
    static constexpr bool PERM = true, AFTER_DRAIN = false;
    bf16_t* O; const float* r1;
    __device__ __forceinline__ void operator()(const f32x4 (&acc)[2][2][4][2], const Unit& u, int wr, int wc, int fr, int fq) const {
        const int row0 = u.pm * 256 + wr * 64 + fr, col0 = u.pn * 256 + wc * 32 + 8 * fq;
        f32x4 s[2][2];
#pragma unroll
        for (int bj = 0; bj < 2; ++bj) { s[bj][0] = *(const f32x4*)(r1 + col0 + bj * 128); s[bj][1] = *(const f32x4*)(r1 + col0 + bj * 128 + 4); }
#pragma unroll
        for (int ai = 0; ai < 2; ++ai)
#pragma unroll
            for (int m = 0; m < 4; ++m) { const int row = row0 + ai * 128 + m * 16;
                bf16_t* rowp = O + (((((size_t)(u.pn >> 5) * NH + (row >> 6)) * NBLK + (u.pn & 31)) * 32 + 4 * wc + fq) * 64 + (row & 63)) * 8;
#pragma unroll
                for (int bj = 0; bj < 2; ++bj) *(u32x4*)(rowp + bj * 16 * 512) = pack8(acc[ai][bj][m][0] * s[bj][0], acc[ai][bj][m][1] * s[bj][1]); }
    }
};
struct EpiGate1 {
    static constexpr bool PERM = true, AFTER_DRAIN = false;
    bf16_t* G;
    __device__ __forceinline__ void operator()(const f32x4 (&acc)[2][2][4][2], const Unit& u, int wr, int wc, int fr, int fq) const {
        const int row0 = u.pm * 256 + wr * 64 + fr, col0 = u.pn * 256 + wc * 32 + 8 * fq;
        u32x4 gw[2][4][2];
#pragma unroll
        for (int ai = 0; ai < 2; ++ai)
#pragma unroll
            for (int m = 0; m < 4; ++m)
#pragma unroll
                for (int bj = 0; bj < 2; ++bj) gw[ai][m][bj] = *(const u32x4*)(G + (size_t)(row0 + ai * 128 + m * 16) * 1024 + col0 + bj * 128);
        asm volatile("" ::: "memory");
#pragma unroll
        for (int ai = 0; ai < 2; ++ai)
#pragma unroll
            for (int m = 0; m < 4; ++m) { bf16_t* rowp = G + (size_t)(row0 + ai * 128 + m * 16) * 1024 + col0;
#pragma unroll
                for (int bj = 0; bj < 2; ++bj) { f32x4 s0, s1; unpack8(gw[ai][m][bj], s0, s1);
                    *(u32x4*)(rowp + bj * 128) = pack8(acc[ai][bj][m][0] * s0, acc[ai][bj][m][1] * s1); } }
    }
};
struct EpiGate2 {
    static constexpr bool PERM = true, AFTER_DRAIN = false;
    bf16_t* G; const bf16_t* Gb;
    __device__ __forceinline__ void operator()(const f32x4 (&acc)[2][2][4][2], const Unit& u, int wr, int wc, int fr, int fq) const {
        const int row0 = u.pm * 256 + wr * 64 + fr, col0 = u.pn * 256 + wc * 32 + 8 * fq;
#pragma unroll
        for (int ai = 0; ai < 2; ++ai) {
            u32x4 gw[4][2], bw[4][2];
#pragma unroll
            for (int m = 0; m < 4; ++m)
#pragma unroll
                for (int bj = 0; bj < 2; ++bj) { const size_t off = (size_t)(row0 + ai * 128 + m * 16) * 1024 + col0 + bj * 128; gw[m][bj] = *(const u32x4*)(G + off); bw[m][bj] = *(const u32x4*)(Gb + off); }
#pragma unroll
            for (int m = 0; m < 4; ++m)
#pragma unroll
                for (int bj = 0; bj < 2; ++bj) { const size_t off = (size_t)(row0 + ai * 128 + m * 16) * 1024 + col0 + bj * 128;
                    f32x4 a0, a1, s0, s1; unpack8(gw[m][bj], a0, a1); unpack8(bw[m][bj], s0, s1);
                    *(u32x4*)(G + off) = pack8(a0 + acc[ai][bj][m][0] * s0, a1 + acc[ai][bj][m][1] * s1); }
        }
    }
};
template <bool BASE_BF16> struct EpiRes {
    static constexpr bool PERM = true, AFTER_DRAIN = false;
    const void* base; bf16_t* xb; float* part;
    __device__ __forceinline__ void operator()(const f32x4 (&acc)[2][2][4][2], const Unit& u, int wr, int wc, int fr, int fq) const {
        const int row0 = u.pm * 256 + wr * 64 + fr, col0 = u.pn * 256 + wc * 32 + 8 * fq;
#pragma unroll
        for (int ai = 0; ai < 2; ++ai) {
            f32x4 b0[4][2], b1[4][2];
#pragma unroll
            for (int m = 0; m < 4; ++m)
#pragma unroll
                for (int bj = 0; bj < 2; ++bj) { const size_t off = (size_t)(row0 + ai * 128 + m * 16) * 1024 + col0 + bj * 128;
                    if (BASE_BF16) unpack8(*(const u32x4*)((const bf16_t*)base + off), b0[m][bj], b1[m][bj]); else { b0[m][bj] = *(const f32x4*)((const float*)base + off); b1[m][bj] = *(const f32x4*)((const float*)base + off + 4); } }
            asm volatile("" ::: "memory");
            float ss4[4];
#pragma unroll
            for (int m = 0; m < 4; ++m) { const int row = row0 + ai * 128 + m * 16; float ss = 0.f;
#pragma unroll
                for (int bj = 0; bj < 2; ++bj) { const size_t off = (size_t)row * 1024 + col0 + bj * 128;
                    const f32x4 v0 = b0[m][bj] + acc[ai][bj][m][0], v1 = b1[m][bj] + acc[ai][bj][m][1];
                    *(u32x4*)(xb + off) = pack8(v0, v1); ss += dot4(v0) + dot4(v1); }
                ss4[m] = ss; }
#pragma unroll
            for (int m = 0; m < 4; ++m) ss4[m] += __shfl_xor(ss4[m], 16);
#pragma unroll
            for (int m = 0; m < 4; ++m) ss4[m] += __shfl_xor(ss4[m], 32);
#pragma unroll
            for (int m = 0; m < 4; ++m) if (fq == 0) part[(size_t)(row0 + ai * 128 + m * 16) * 16 + u.pn * 4 + wc] = ss4[m];
        }
    }
};
__device__ __forceinline__ float row_rs(const float* part, int row, int fq) {
    const f32x4 pv = *(const f32x4*)(part + (size_t)row * 16 + 4 * fq); float s = (pv[0] + pv[1]) + (pv[2] + pv[3]);
    s += __shfl_xor(s, 16); s += __shfl_xor(s, 32); return rsqrtf(s * (1.f / 1024.f) + EPS);
}
__device__ __forceinline__ void rows_rs8(const float* part, int row0, int fq, float (&r)[8]) {
    f32x4 pv[8];
#pragma unroll
    for (int i = 0; i < 8; ++i) pv[i] = *(const f32x4*)(part + (size_t)(row0 + (i >> 2) * 128 + (i & 3) * 16) * 16 + 4 * fq);
#pragma unroll
    for (int i = 0; i < 8; ++i) r[i] = (pv[i][0] + pv[i][1]) + (pv[i][2] + pv[i][3]);
#pragma unroll
    for (int i = 0; i < 8; ++i) r[i] += __shfl_xor(r[i], 16);
#pragma unroll
    for (int i = 0; i < 8; ++i) r[i] += __shfl_xor(r[i], 32);
#pragma unroll
    for (int i = 0; i < 8; ++i) r[i] = rsqrtf(r[i] * (1.f / 1024.f) + EPS);
}
struct EpiSwiGLU {
    static constexpr bool PERM = true, AFTER_DRAIN = false;
    bf16_t* O; const float* part;
    __device__ __forceinline__ void operator()(const f32x4 (&acc)[2][2][4][2], const Unit& u, int wr, int wc, int fr, int fq) const {
        const int row0 = u.pm * 256 + wr * 64 + fr, col0 = u.pn * 128 + wc * 32 + 8 * fq;
        float rr[8]; rows_rs8(part, row0, fq, rr);
#pragma unroll
        for (int ai = 0; ai < 2; ++ai)
#pragma unroll
            for (int m = 0; m < 4; ++m) { const int row = row0 + ai * 128 + m * 16; const float r = rr[ai * 4 + m];
                f32x4 a0, a1;
#pragma unroll
                for (int j = 0; j < 4; ++j) { a0[j] = siluf(acc[ai][0][m][0][j] * r) * (acc[ai][1][m][0][j] * r); a1[j] = siluf(acc[ai][0][m][1][j] * r) * (acc[ai][1][m][1][j] * r); }
                *(u32x4*)(O + (size_t)row * DFF + col0) = pack8(a0, a1); }
    }
};
struct EpiPle {
    static constexpr bool PERM = true, AFTER_DRAIN = false;
    float* out; const bf16_t* x2b; const bf16_t* pp; const float* part;
    __device__ __forceinline__ void operator()(const f32x4 (&acc)[2][2][4][2], const Unit& u, int wr, int wc, int fr, int fq) const {
        const int row0 = u.pm * 256 + wr * 64 + fr, col0 = u.pn * 256 + wc * 32 + 8 * fq;
        float rr[8]; rows_rs8(part, row0, fq, rr);
#pragma unroll
        for (int ai = 0; ai < 2; ++ai) {
            u32x4 pw[4][2], xw[4][2];
#pragma unroll
            for (int m = 0; m < 4; ++m)
#pragma unroll
                for (int bj = 0; bj < 2; ++bj) { const size_t off = (size_t)(row0 + ai * 128 + m * 16) * 1024 + col0 + bj * 128; pw[m][bj] = *(const u32x4*)(pp + off); xw[m][bj] = *(const u32x4*)(x2b + off); }
#pragma unroll
            for (int m = 0; m < 4; ++m) { const float r = rr[ai * 4 + m];
#pragma unroll
                for (int bj = 0; bj < 2; ++bj) { const size_t off = (size_t)(row0 + ai * 128 + m * 16) * 1024 + col0 + bj * 128;
                    f32x4 p0, p1, v0, v1; unpack8(pw[m][bj], p0, p1); unpack8(xw[m][bj], v0, v1);
#pragma unroll
                    for (int j = 0; j < 4; ++j) { v0[j] += p0[j] * sigm(acc[ai][bj][m][0][j] * r); v1[j] += p1[j] * sigm(acc[ai][bj][m][1][j] * r); }
                    *(f32x4*)(out + off) = v0; *(f32x4*)(out + off + 4) = v1; } }
        }
    }
};
}

struct Args { const float* in[21]; float* out; unsigned char* ws; };
enum { I_X = 0, I_P, I_LN1, I_WIN, I_GQ, I_GK, I_WOA, I_CONVW, I_CONVB, I_DTB, I_ALOG, I_DSKIP, I_SSMG, I_WOS, I_WOUT, I_LN2, I_WGU, I_WDN, I_LN3, I_WPG, I_WPP };

template <class MapF>
__device__ __forceinline__ void p0_transpose_item(const float* W, int K, int N, const float* gk, bf16* WT, LAS float* scr, int item, int lane, MapF map) {
    const int nblk = N / 32, kb = item / nblk, nb = item % nblk, k0 = 64 * kb, n0 = 32 * nb;
    float wv[32], gs[32];
#pragma unroll
    for (int i = 0; i < 32; ++i) wv[i] = W[(size_t)(k0 + 2 * i + (lane >> 5)) * N + n0 + (lane & 31)];
#pragma unroll
    for (int i = 0; i < 32; ++i) gs[i] = gk ? gk[k0 + 2 * i + (lane >> 5)] : 1.f;
    asm volatile("" ::: "memory");
#pragma unroll
    for (int i = 0; i < 32; ++i) { const int kk = 2 * i + (lane >> 5); scr[kk * 33 + (lane & 31)] = wv[i] * gs[i]; }
    LDS_WAIT(); asm volatile("" ::: "memory");
    const int c = lane & 7;
#pragma unroll
    for (int j = 0; j < 4; ++j) { const int n = (lane >> 3) + 8 * j; const LAS float* s = scr + (8 * c) * 33 + n;
        v4u o; o.x = pk2(s[0 * 33], s[1 * 33]); o.y = pk2(s[2 * 33], s[3 * 33]); o.z = pk2(s[4 * 33], s[5 * 33]); o.w = pk2(s[6 * 33], s[7 * 33]);
        *(v4u*)(WT + (size_t)map(n0 + n) * K + k0 + 8 * c) = o; }
    LDS_WAIT(); asm volatile("" ::: "memory");
}
struct MapId { __device__ __forceinline__ int operator()(int n) const { return n; } };
struct MapWin { __device__ __forceinline__ int operator()(int n) const {
    if (n < 2048) { const int l = n & 255; return (n & ~255) + 128 * ((l >> 5) & 1) + 32 * (l >> 6) + (l & 31); }
    if (n < 3072) return n;
    if (n < 5120) return 6144 + (n - 3072);
    if (n < 8192) return 3072 + (n - 5120);
    if (n < 8224) return 10240 + (n - 8192);
    return 8192 + (n - 8224); } };
struct MapGU { __device__ __forceinline__ int operator()(int n) const { const int up = n >= DFF ? 1 : 0, idx = n - up * DFF; return (idx >> 7) * 256 + up * 128 + (idx & 127); } };

__device__ __forceinline__ void p0_prologue(const Args& a, LAS unsigned char* lds, int gw, int NGW, int wave, int lane) {
    unsigned char* ws = a.ws;
    LAS float* scr = (LAS float*)(lds + wave * 16384);
    constexpr int I_IN = 16 * (IN_DIM / 32), I_SQ = 16 * 32, I_OS = 32 * 32, I_GU = 16 * (2 * DFF / 32), I_DN = (DFF / 64) * 32, I_PP = 4 * 32;
    constexpr int NITEMS = I_IN + 3 * I_SQ + I_OS + I_GU + I_DN + I_PP;
    for (int it = gw; it < NITEMS; it += NGW) {
        int r = it;
        if (r < I_IN) { p0_transpose_item(a.in[I_WIN], DM, IN_DIM, a.in[I_LN1], (bf16*)(ws + WS_WIN), scr, r, lane, MapWin()); continue; } r -= I_IN;
        if (r < I_SQ) { p0_transpose_item(a.in[I_WOA], DM, DM, nullptr, (bf16*)(ws + WS_WOA), scr, r, lane, MapId()); continue; } r -= I_SQ;
        if (r < I_SQ) { p0_transpose_item(a.in[I_WOUT], DM, DM, nullptr, (bf16*)(ws + WS_WOUT), scr, r, lane, MapId()); continue; } r -= I_SQ;
        if (r < I_SQ) { p0_transpose_item(a.in[I_WPG], DM, DM, a.in[I_LN3], (bf16*)(ws + WS_WPG), scr, r, lane, MapId()); continue; } r -= I_SQ;
        if (r < I_OS) { p0_transpose_item(a.in[I_WOS], SSM_IN, DM, nullptr, (bf16*)(ws + WS_WOS), scr, r, lane, MapId()); continue; } r -= I_OS;
        if (r < I_GU) { p0_transpose_item(a.in[I_WGU], DM, 2 * DFF, a.in[I_LN2], (bf16*)(ws + WS_WGU), scr, r, lane, MapGU()); continue; } r -= I_GU;
        if (r < I_DN) { p0_transpose_item(a.in[I_WDN], DFF, DM, nullptr, (bf16*)(ws + WS_WDN), scr, r, lane, MapId()); continue; } r -= I_DN;
        p0_transpose_item(a.in[I_WPP], PLE, DM, nullptr, (bf16*)(ws + WS_WPP), scr, r, lane, MapId());
    }
    float* r1 = (float*)(ws + WS_R1); bf16* xb = (bf16*)((unsigned char*)a.out + OUT_XB);
    for (int m0 = gw; m0 < M; m0 += 4 * NGW) {
        f32x4 v[4][4]; float sq[4];
#pragma unroll
        for (int r = 0; r < 4; ++r) { const int m = m0 + r * NGW; const f32x4* xr = (const f32x4*)(a.in[I_X] + (size_t)(m < M ? m : m0) * DM) + lane;
#pragma unroll
            for (int j = 0; j < 4; ++j) v[r][j] = xr[64 * j]; }
#pragma unroll
        for (int r = 0; r < 4; ++r) { float s = 0.f;
#pragma unroll
            for (int j = 0; j < 4; ++j) s += (v[r][j][0] * v[r][j][0] + v[r][j][1] * v[r][j][1]) + (v[r][j][2] * v[r][j][2] + v[r][j][3] * v[r][j][3]);
            sq[r] = s; }
#pragma unroll
        for (int o = 1; o < 64; o <<= 1) {
#pragma unroll
            for (int r = 0; r < 4; ++r) sq[r] += __shfl_xor(sq[r], o); }
#pragma unroll
        for (int r = 0; r < 4; ++r) { const int m = m0 + r * NGW; if (m < M) {
            if (lane == 0) r1[m] = rsqrtf(sq[r] * (1.f / DM) + EPS);
            unsigned long long* o8 = (unsigned long long*)(xb + (size_t)m * DM) + lane;
#pragma unroll
            for (int j = 0; j < 4; ++j) o8[64 * j] = (unsigned long long)pk2(v[r][j][0], v[r][j][1]) | ((unsigned long long)pk2(v[r][j][2], v[r][j][3]) << 32); } }
    }
    { const size_t n8 = (size_t)M * PLE / 8, st = (size_t)NGW * 64; const f32x4* ps = (const f32x4*)a.in[I_P]; v4u* pd = (v4u*)(ws + WS_PB);
      for (size_t i0 = (size_t)gw * 64 + lane; i0 < n8; i0 += 4 * st) { f32x4 a0[4], a1[4];
#pragma unroll
          for (int r = 0; r < 4; ++r) { const size_t i = i0 + r * st < n8 ? i0 + r * st : i0; a0[r] = ps[2 * i]; a1[r] = ps[2 * i + 1]; }
#pragma unroll
          for (int r = 0; r < 4; ++r) { const size_t i = i0 + r * st; if (i < n8) { v4u o; o.x = pk2(a0[r][0], a0[r][1]); o.y = pk2(a0[r][2], a0[r][3]); o.z = pk2(a1[r][0], a1[r][1]); o.w = pk2(a1[r][2], a1[r][3]); pd[i] = o; } } } }
}

__device__ __forceinline__ void dt_phase(const Args& a, LAS unsigned char* lds, int tid_, int wave_, int lane_) {
    const int wave = wave_, lane = pg8::fresh_lane(), tid = wave * 64 + lane; (void)tid_; (void)lane_;
    const bf16* xb = (const bf16*)((const unsigned char*)a.out + OUT_XB); const bf16* wdt = (const bf16*)(a.ws + WS_WIN) + (size_t)10240 * DM;
    const float* r1 = (const float*)(a.ws + WS_R1); float* dt = (float*)(a.ws + WS_DT);
    LAS float* part = (LAS float*)lds;
    const int fr = lane & 15, fq = lane >> 4;
    for (int it = blockIdx.x; it < M / 64; it += gridDim.x) {
        const bf16* ap = xb + (size_t)(it * 64 + fr) * DM + wave * 128 + 8 * fq; const bf16* bp = wdt + (size_t)fr * DM + wave * 128 + 8 * fq;
        bf16x8 af[4][4], bfr[4][2];
#pragma unroll
        for (int ks = 0; ks < 4; ++ks) {
#pragma unroll
            for (int m = 0; m < 4; ++m) af[ks][m] = *(const bf16x8*)(ap + (size_t)m * 16 * DM + ks * 32);
#pragma unroll
            for (int n = 0; n < 2; ++n) bfr[ks][n] = *(const bf16x8*)(bp + (size_t)n * 16 * DM + ks * 32); }
        f32x4 acc[4][2];
#pragma unroll
        for (int m = 0; m < 4; ++m) { acc[m][0] = (f32x4){0.f, 0.f, 0.f, 0.f}; acc[m][1] = (f32x4){0.f, 0.f, 0.f, 0.f}; }
#pragma unroll
        for (int ks = 0; ks < 4; ++ks)
#pragma unroll
            for (int m = 0; m < 4; ++m)
#pragma unroll
                for (int n = 0; n < 2; ++n) acc[m][n] = __builtin_amdgcn_mfma_f32_16x16x32_bf16(bfr[ks][n], af[ks][m], acc[m][n], 0, 0, 0);
#pragma unroll
        for (int m = 0; m < 4; ++m)
#pragma unroll
            for (int n = 0; n < 2; ++n) *(LAS f32x4*)(part + ((wave * 64 + lane) * 8 + m * 2 + n) * 4) = acc[m][n];
        __syncthreads();
        { const int l2 = tid & 63, mn = tid >> 6, m = mn >> 1, n = mn & 1, fr2 = l2 & 15, fq2 = l2 >> 4;
          f32x4 s = (f32x4){0.f, 0.f, 0.f, 0.f};
#pragma unroll
          for (int w = 0; w < 8; ++w) s += *(const LAS f32x4*)(part + ((w * 64 + l2) * 8 + mn) * 4);
          const int row = it * 64 + 16 * m + fr2; const float rs = r1[row]; const f32x4 bb = *(const f32x4*)(a.in[I_DTB] + 16 * n + 4 * fq2); f32x4 o;
#pragma unroll
          for (int j = 0; j < 4; ++j) { const float x = s[j] * rs + bb[j]; o[j] = x > 20.f ? x : log1pf(expf(x)); }
          *(f32x4*)(dt + (size_t)row * SSM_H + 16 * n + 4 * fq2) = o; }
        __syncthreads();
    }
}

constexpr int SL = 256, NCH = SEQ / SL;
constexpr size_t OUT_ST = 32 * MiB;
constexpr size_t WS_DEC = 512 * 1024;
constexpr int XT_LD = 264, BN_LD = 136;
__device__ __forceinline__ f32x4 mfma16(bf16x8 a, bf16x8 b, f32x4 c) { return __builtin_amdgcn_mfma_f32_16x16x32_bf16(a, b, c, 0, 0, 0); }
__device__ __forceinline__ void unpk8(v4u w, float (&o)[8]) {
    o[0] = __uint_as_float(w.x << 16); o[1] = __uint_as_float(w.x & 0xffff0000u); o[2] = __uint_as_float(w.y << 16); o[3] = __uint_as_float(w.y & 0xffff0000u);
    o[4] = __uint_as_float(w.z << 16); o[5] = __uint_as_float(w.z & 0xffff0000u); o[6] = __uint_as_float(w.w << 16); o[7] = __uint_as_float(w.w & 0xffff0000u); }
template <int NR> __device__ __forceinline__ void conv_load(const bf16* xb, int t0, v4u (&raw)[NR + 3]) {
#pragma unroll
    for (int i = 0; i < NR + 3; ++i) { const int t = t0 - 3 + i; raw[i] = t >= 0 ? *(const v4u*)(xb + (size_t)t * CONVD) : (v4u){0u, 0u, 0u, 0u}; }
}
struct ConvW { float w[4][8], bias[8]; };
__device__ __forceinline__ void conv_loadw(const float* cw, const float* cb, int ch0, ConvW& c) {
#pragma unroll
    for (int k = 0; k < 4; ++k) { const f32x4 x0 = *(const f32x4*)(cw + (size_t)k * CONVD + ch0), x1 = *(const f32x4*)(cw + (size_t)k * CONVD + ch0 + 4);
        c.w[k][0] = x0[0]; c.w[k][1] = x0[1]; c.w[k][2] = x0[2]; c.w[k][3] = x0[3]; c.w[k][4] = x1[0]; c.w[k][5] = x1[1]; c.w[k][6] = x1[2]; c.w[k][7] = x1[3]; }
    { const f32x4 x0 = *(const f32x4*)(cb + ch0), x1 = *(const f32x4*)(cb + ch0 + 4); c.bias[0] = x0[0]; c.bias[1] = x0[1]; c.bias[2] = x0[2]; c.bias[3] = x0[3]; c.bias[4] = x1[0]; c.bias[5] = x1[1]; c.bias[6] = x1[2]; c.bias[7] = x1[3]; }
}
template <int NR> __device__ __forceinline__ void conv_compute_w(const v4u (&raw)[NR + 3], const ConvW& c, float (&out)[NR][8]) {
    float r0[8], r1[8], r2[8], cur[8];
    unpk8(raw[0], r0); unpk8(raw[1], r1); unpk8(raw[2], r2);
#pragma unroll
    for (int r = 0; r < NR; ++r) {
        unpk8(raw[r + 3], cur);
#pragma unroll
        for (int i = 0; i < 8; ++i) { const float v = c.bias[i] + c.w[0][i] * r0[i] + c.w[1][i] * r1[i] + c.w[2][i] * r2[i] + c.w[3][i] * cur[i]; out[r][i] = siluf(v); r0[i] = r1[i]; r1[i] = r2[i]; r2[i] = cur[i]; }
    }
}
template <int NR> __device__ __forceinline__ void conv_compute(const v4u (&raw)[NR + 3], const float* cw, const float* cb, int ch0, float (&out)[NR][8]) { ConvW c; conv_loadw(cw, cb, ch0, c); conv_compute_w<NR>(raw, c, out); }
template <int NR> __device__ __forceinline__ void conv8(const bf16* xb, int t0, const float* cw, const float* cb, int ch0, float (&out)[NR][8]) { v4u raw[NR + 3]; conv_load<NR>(xb, t0, raw); conv_compute<NR>(raw, cw, cb, ch0, out); }
__device__ __forceinline__ float ssd_dt_scan(const Args& a, size_t row0, int h, int lane, float (&d)[4], float (&acs)[4]) {
    const float* DT = (const float*)(a.ws + WS_DT); const float A = -expf(a.in[I_ALOG][h]);
#pragma unroll
    for (int i = 0; i < 4; ++i) d[i] = DT[(row0 + 4 * lane + i) * SSM_H + h];
    const float s1 = d[0] * A, s2 = s1 + d[1] * A, s3 = s2 + d[2] * A, s4 = s3 + d[3] * A;
    float incl = s4;
#pragma unroll
    for (int o = 1; o < 64; o <<= 1) { const float t = __shfl_up(incl, o); if (lane >= o) incl += t; }
    const float excl = incl - s4;
    acs[0] = excl + s1; acs[1] = excl + s2; acs[2] = excl + s3; acs[3] = excl + s4;
    return __shfl(incl, 63);
}
constexpr int S1_W = 0, S1_B = 8192, S1_X = 8192 + 67584;
__device__ __forceinline__ void st_rows8(bf16* dst, bf16* tl, int r0, const float (&o)[8][8]) {
#pragma unroll
    for (int r = 0; r < 8; ++r) { v4u w; w.x = pk2(o[r][0], o[r][1]); w.y = pk2(o[r][2], o[r][3]); w.z = pk2(o[r][4], o[r][5]); w.w = pk2(o[r][6], o[r][7]);
        bf16* p = (r >= 5 && r0 + r >= 253) ? tl + (size_t)(r0 + r - 253) * CONVD : dst + (size_t)r * CONVD; *(v4u*)p = w; }
}
__device__ __forceinline__ void ssd_s1(const Args& a, LAS unsigned char* lds, int tid_, int wave_, int lane_) {
    const int wave = wave_, lane = pg8::fresh_lane(), tid = wave * 64 + lane; (void)tid_; (void)lane_;
    bf16* XBC = (bf16*)(a.ws + WS_XBC); bf16* TAIL = (bf16*)(a.ws + WS_TAIL); bf16* ST = (bf16*)((unsigned char*)a.out + OUT_ST); float* DEC = (float*)(a.ws + WS_DEC);
    LAS float* W8 = (LAS float*)(lds + S1_W); LAS bf16* BT = (LAS bf16*)(lds + S1_B); LAS bf16* XT = (LAS bf16*)(lds + S1_X);
    const int fr = lane & 15, fq = lane >> 4, chunk = tid & 15, r0 = 8 * (tid >> 4);
    for (int unit = blockIdx.x; unit < BATCH * NCH * SSM_G; unit += gridDim.x) {
        const int g = unit & 3, c = (unit >> 2) & 31, b = unit >> 7; const size_t rowb = (size_t)b * SEQ; const int t0c = c * SL;
        bf16* xrow = XBC + rowb * CONVD; bf16* tlb = TAIL + (size_t)((b * NCH + c) * 3) * CONVD;
        v4u raw[11]; ConvW cwx;
        { const int ch0 = g * 512 + (chunk >> 3) * 64 + 8 * (chunk & 7); conv_load<8>(xrow + ch0, t0c + r0, raw); }
        { const int h = g * 8 + wave; float d[4], acs[4]; const float tot = ssd_dt_scan(a, rowb + t0c, h, lane, d, acs); if (lane == 0) DEC[(b * NCH + c) * 32 + h] = expf(tot);
          *(LAS f32x4*)(W8 + wave * 256 + 4 * lane) = (f32x4){d[0] * __expf(tot - acs[0]), d[1] * __expf(tot - acs[1]), d[2] * __expf(tot - acs[2]), d[3] * __expf(tot - acs[3])}; }
        { const int ch0 = 2048 + g * 128 + 8 * chunk; float o[8][8]; v4u rawb[11];
          conv_load<8>(xrow + ch0, t0c + r0, rawb); ConvW cwb; conv_loadw(a.in[I_CONVW], a.in[I_CONVB], ch0, cwb);
          asm volatile("s_waitcnt vmcnt(0)" ::: "memory"); __syncthreads();
          conv_compute_w<8>(rawb, cwb, o);
#pragma unroll
          for (int i = 0; i < 8; ++i) { v4u w; w.x = pk2(o[0][i], o[1][i]); w.y = pk2(o[2][i], o[3][i]); w.z = pk2(o[4][i], o[5][i]); w.w = pk2(o[6][i], o[7][i]); *(LAS v4u*)(BT + (8 * chunk + i) * XT_LD + r0) = w; }
          st_rows8(xrow + (size_t)(t0c + r0) * CONVD + ch0, tlb + ch0, r0, o); }
        conv_loadw(a.in[I_CONVW], a.in[I_CONVB], g * 512 + (chunk >> 3) * 64 + 8 * (chunk & 7), cwx);
        __syncthreads();
        for (int pr = 0; pr < 4; ++pr) {
            { const int hj = 2 * pr + (chunk >> 3), ch0 = g * 512 + hj * 64 + 8 * (chunk & 7); float o[8][8];
              conv_compute_w<8>(raw, cwx, o);
              st_rows8(xrow + (size_t)(t0c + r0) * CONVD + ch0, tlb + ch0, r0, o);
#pragma unroll
              for (int r = 0; r < 8; ++r) { const float wgt = W8[hj * 256 + r0 + r];
#pragma unroll
                  for (int i = 0; i < 8; ++i) o[r][i] *= wgt; }
#pragma unroll
              for (int i = 0; i < 8; ++i) { v4u w; w.x = pk2(o[0][i], o[1][i]); w.y = pk2(o[2][i], o[3][i]); w.z = pk2(o[4][i], o[5][i]); w.w = pk2(o[6][i], o[7][i]); *(LAS v4u*)(XT + (8 * chunk + i) * XT_LD + r0) = w; } }
            __syncthreads();
            { const int ch0 = pr < 3 ? g * 512 + (2 * pr + 2 + (chunk >> 3)) * 64 + 8 * (chunk & 7) : 2560 + g * 128 + 8 * chunk;
              conv_load<8>(xrow + ch0, t0c + r0, raw); conv_loadw(a.in[I_CONVW], a.in[I_CONVB], ch0, cwx); }
            const int e = wave >> 2, pt = wave & 3, h = g * 8 + 2 * pr + e;
            f32x4 acc[8];
#pragma unroll
            for (int nt = 0; nt < 8; ++nt) acc[nt] = (f32x4){0.f, 0.f, 0.f, 0.f};
            { bf16x8 xf[2], bfr[2][8];
#define S1_LD(ks_, set_) do { xf[set_] = *(const LAS bf16x8*)(XT + (e * 64 + pt * 16 + fr) * XT_LD + 32 * (ks_) + 8 * fq); \
                _Pragma("unroll") for (int nt = 0; nt < 8; ++nt) bfr[set_][nt] = *(const LAS bf16x8*)(BT + (nt * 16 + fr) * XT_LD + 32 * (ks_) + 8 * fq); } while (0)
              S1_LD(0, 0);
#pragma unroll
              for (int ks = 0; ks < 8; ++ks) {
                  if (ks < 7) S1_LD(ks + 1, (ks + 1) & 1);
                  asm volatile("" ::: "memory");
#pragma unroll
                  for (int nt = 0; nt < 8; ++nt) acc[nt] = mfma16(bfr[ks & 1][nt], xf[ks & 1], acc[nt]);
              }
#undef S1_LD
            }
            bf16* dst = ST + ((((size_t)b * 32 + h) * NCH + c) * 64 + pt * 16 + fr) * 128 + 4 * fq;
#pragma unroll
            for (int nt = 0; nt < 8; ++nt) *(unsigned long long*)(dst + nt * 16) = (unsigned long long)pk2(acc[nt][0], acc[nt][1]) | ((unsigned long long)pk2(acc[nt][2], acc[nt][3]) << 32);
            asm volatile("s_waitcnt vmcnt(0)" ::: "memory");
            __syncthreads();
        }
        { const int ch0 = 2560 + g * 128 + 8 * chunk; float o[8][8];
          conv_compute_w<8>(raw, cwx, o);
          st_rows8(xrow + (size_t)(t0c + r0) * CONVD + ch0, tlb + ch0, r0, o); }
    }
}
__device__ __forceinline__ void ssd_s2(const Args& a, int tid_) {
    const int tid = tid_;
    unsigned long long* ST = (unsigned long long*)((unsigned char*)a.out + OUT_ST); const float* DEC = (const float*)(a.ws + WS_DEC);
    for (int e = blockIdx.x * NTHR + tid; e < BATCH * 32 * 2048; e += gridDim.x * NTHR) {
        const int b = e >> 16, h = (e >> 11) & 31, q4 = e & 2047;
        unsigned long long* p = ST + ((size_t)(b * 32 + h) * NCH) * 2048 + q4; constexpr size_t cst = 2048;
        unsigned long long w[NCH]; float dv[NCH];
#pragma unroll
        for (int c = 0; c < NCH; ++c) w[c] = p[c * cst];
#pragma unroll
        for (int c = 0; c < NCH; ++c) dv[c] = DEC[(b * NCH + c) * 32 + h];
        asm volatile("" ::: "memory");
        float s0 = 0.f, s1 = 0.f, s2 = 0.f, s3 = 0.f;
#pragma unroll
        for (int c = 0; c < NCH; ++c) { const float dec = dv[c];
            p[c * cst] = (unsigned long long)pk2(s0, s1) | ((unsigned long long)pk2(s2, s3) << 32);
            const unsigned lo = (unsigned)w[c], hi = (unsigned)(w[c] >> 32);
            s0 = s0 * dec + __uint_as_float(lo << 16); s1 = s1 * dec + __uint_as_float(lo & 0xffff0000u); s2 = s2 * dec + __uint_as_float(hi << 16); s3 = s3 * dec + __uint_as_float(hi & 0xffff0000u); }
    }
}
constexpr int S3_BSZ = 73728  , S3_ACS = 0, S3_DTS = 8192, S3_SSQ = 16384, S3_B = 17408, S3_X = 17408 + S3_BSZ, S3_P = 17408 + S3_BSZ + 34816, S3_W3 = 17408 + S3_BSZ + 34816 + 16384, S3_P2 = S3_W3 + 1024;
__device__ __forceinline__ void ssd_s3(const Args& a, LAS unsigned char* lds, int tid_, int wave_, int lane_) {
    const int wave = wave_, lane = pg8::fresh_lane(), tid = wave * 64 + lane; (void)tid_; (void)lane_;
    const bf16* XBC = (const bf16*)(a.ws + WS_XBC); const bf16* ST = (const bf16*)((const unsigned char*)a.out + OUT_ST); bf16* Z = (bf16*)(a.ws + WS_Z);
    LAS float* acsL = (LAS float*)(lds + S3_ACS); LAS float* dtsL = (LAS float*)(lds + S3_DTS); LAS float* ssq = (LAS float*)(lds + S3_SSQ);
    LAS bf16* Bn = (LAS bf16*)(lds + S3_B); LAS bf16* XT = (LAS bf16*)(lds + S3_X); LAS float* W3 = (LAS float*)(lds + S3_W3);
    const int fr = lane & 15, fq = lane >> 4, xchunk = tid & 7, xr0 = 4 * (tid >> 3);
    for (int unit = blockIdx.x; unit < BATCH * NCH * SSM_G; unit += gridDim.x) {
        const int g = unit & 3, c = (unit >> 2) & 31, b = unit >> 7; const size_t rowb = (size_t)b * SEQ; const int t0c = c * SL;
        const bf16* tlb = (const bf16*)(a.ws + WS_TAIL) + (size_t)((b * NCH + c) * 3) * CONVD;
        { float d[4], acs[4]; (void)ssd_dt_scan(a, rowb + t0c, g * 8 + wave, lane, d, acs);
          constexpr float L2E = 1.4426950408889634f; *(LAS f32x4*)(acsL + wave * 256 + 4 * lane) = (f32x4){acs[0] * L2E, acs[1] * L2E, acs[2] * L2E, acs[3] * L2E}; *(LAS f32x4*)(dtsL + wave * 256 + 4 * lane) = (f32x4){d[0], d[1], d[2], d[3]}; }
        if (tid < 256) ssq[tid] = 0.f;
        bf16x8 cf[2][4];
#pragma unroll
        for (int st = 0; st < 2; ++st) {
            { const int t2 = tid & 255, chunk = t2 & 15, r0 = 8 * (t2 >> 4);
              const bool isC = tid < 256; const int rr = isC ? st * 128 + r0 : st * 128 + r0, ch0 = (isC ? 2560 : 2048) + g * 128 + 8 * chunk;
              const bf16* src = XBC + (rowb + t0c + rr) * CONVD + ch0; v4u w[8];
#pragma unroll
              for (int r = 0; r < 8; ++r) w[r] = *(const v4u*)((r >= 5 && rr + r >= 253) ? tlb + (size_t)(rr + r - 253) * CONVD + ch0 : src + (size_t)r * CONVD);
              LAS bf16* dstl = isC ? XT + r0 * BN_LD + 8 * chunk : Bn + (st * 128 + r0) * BN_LD + 8 * chunk;
#pragma unroll
              for (int r = 0; r < 8; ++r) *(LAS v4u*)(dstl + r * BN_LD) = w[r]; }
            __syncthreads();
            { const int lrel = (st ? 15 - wave : wave) * 16 - st * 128 + fr;
#pragma unroll
              for (int ks = 0; ks < 4; ++ks) cf[st][ks] = *(const LAS bf16x8*)(XT + lrel * BN_LD + 32 * ks + 8 * fq); }
            __syncthreads();
        }
        LAS unsigned char* SW = lds + S3_B + wave * 9216 + lane * 16;
        {   v4u stw[9];
#pragma unroll
            for (int q = 0; q < 9; ++q) {
                const int n0 = (wave >> 1) + 1, st = q < n0 ? 0 : 1, t = st ? q - n0 : q, s0 = 32 * t;
                f32x4 sa = (f32x4){0.f, 0.f, 0.f, 0.f}, sb = sa;
                bf16x8 b0[4], b1[4];
#pragma unroll
                for (int ks = 0; ks < 4; ++ks) { b0[ks] = *(const LAS bf16x8*)(Bn + (s0 + fr) * BN_LD + 32 * ks + 8 * fq); b1[ks] = *(const LAS bf16x8*)(Bn + (s0 + 16 + fr) * BN_LD + 32 * ks + 8 * fq); }
                asm volatile("" ::: "memory");
#pragma unroll
                for (int ks = 0; ks < 4; ++ks) { const bf16x8 c0 = st ? cf[1][ks] : cf[0][ks];
                    sa = mfma16(b0[ks], c0, sa); sb = mfma16(b1[ks], c0, sb); }
                stw[q].x = pk2(sa[0], sa[1]); stw[q].y = pk2(sa[2], sa[3]); stw[q].z = pk2(sb[0], sb[1]); stw[q].w = pk2(sb[2], sb[3]);
            }
            __syncthreads();
#pragma unroll
            for (int q = 0; q < 9; ++q) *(LAS v4u*)(SW + q * 1024) = stw[q];
        }
        v4u raw[4];
#define S3_LDX(jj) do { const int ch_ = g * 512 + (jj) * 64 + 8 * xchunk; const bf16* xs_ = XBC + (rowb + t0c + xr0) * CONVD + ch_; \
            _Pragma("unroll") for (int r = 0; r < 4; ++r) raw[r] = *(const v4u*)((r >= 1 && xr0 + r >= 253) ? tlb + (size_t)(xr0 + r - 253) * CONVD + ch_ : xs_ + (size_t)r * CONVD); } while (0)
        S3_LDX(0);
#define S3_DMA(jj) do { const bf16* pvg_ = ST + ((((size_t)b * 32 + g * 8 + (jj)) * NCH + c) * 64) * 128; LAS unsigned char* pvl_ = lds + (((jj) & 1) ? S3_P2 : S3_P); \
            _Pragma("unroll") for (int i = 0; i < 2; ++i) { const int L = i * 512 + tid, row = L >> 4, cpos = L & 15; \
                __builtin_amdgcn_global_load_lds((const unsigned*)(pvg_ + (size_t)row * 128 + 8 * (cpos ^ (row & 15))), (__attribute__((address_space(3))) unsigned*)(pvl_ + (i * 512 + wave * 64) * 16), 16, 0, 0); } } while (0)
        S3_DMA(0);
        for (int j = 0; j < 8; ++j) {
            const int h = g * 8 + j; const float Dj = a.in[I_DSKIP][h];
            LAS unsigned char* PV = lds + ((j & 1) ? S3_P2 : S3_P);
            if (tid < 256) W3[tid] = dtsL[j * 256 + tid] * __builtin_amdgcn_exp2f(acsL[j * 256 + (tid | 31)] - acsL[j * 256 + tid]);
            {
#pragma unroll
                for (int i2 = 0; i2 < 4; ++i2) {
                    const unsigned a0 = raw[0][i2], a1 = raw[1][i2], a2 = raw[2][i2], a3 = raw[3][i2];
                    const unsigned e01 = __builtin_amdgcn_perm(a1, a0, 0x05040100u), e23 = __builtin_amdgcn_perm(a3, a2, 0x05040100u);
                    const unsigned o01 = __builtin_amdgcn_perm(a1, a0, 0x07060302u), o23 = __builtin_amdgcn_perm(a3, a2, 0x07060302u);
                    *(LAS unsigned long long*)(XT + (8 * xchunk + 2 * i2) * XT_LD + xr0) = (unsigned long long)e01 | ((unsigned long long)e23 << 32);
                    *(LAS unsigned long long*)(XT + (8 * xchunk + 2 * i2 + 1) * XT_LD + xr0) = (unsigned long long)o01 | ((unsigned long long)o23 << 32); } }
            __syncthreads();
            if (j < 7) { S3_DMA(j + 1); S3_LDX(j + 1); }
            unsigned long long zw[2][4];
#pragma unroll
            for (int st = 0; st < 2; ++st) { const int l = (st ? 15 - wave : wave) * 16 + fr; const bf16* zp = Z + (rowb + t0c + l) * SSM_IN + h * 64 + 4 * fq;
#pragma unroll
                for (int pt = 0; pt < 4; ++pt) zw[st][pt] = *(const unsigned long long*)(zp + pt * 16); }
#pragma unroll
            for (int st = 0; st < 2; ++st) {
                const int strip = st ? 15 - wave : wave, l = strip * 16 + fr;
                f32x4 y[4];
#pragma unroll
                for (int pt = 0; pt < 4; ++pt) y[pt] = (f32x4){0.f, 0.f, 0.f, 0.f};
                { bf16x8 pf[2][4];
#define S3_PLD(ks_, set_) do { _Pragma("unroll") for (int pt = 0; pt < 4; ++pt) { const int prow = pt * 16 + fr; pf[set_][pt] = *(const LAS bf16x8*)(PV + prow * 256 + (((4 * (ks_) + fq) ^ (prow & 15)) << 4)); } } while (0)
                  S3_PLD(0, 0);
#pragma unroll
                  for (int ks = 0; ks < 4; ++ks) {
                      if (ks < 3) S3_PLD(ks + 1, (ks + 1) & 1);
                      asm volatile("" ::: "memory");
#pragma unroll
                      for (int pt = 0; pt < 4; ++pt) y[pt] = mfma16(pf[ks & 1][pt], cf[st][ks], y[pt]);
                  }
#undef S3_PLD
                }
                const float al = acsL[j * 256 + l], el = __builtin_amdgcn_exp2f(al);
#pragma unroll
                for (int pt = 0; pt < 4; ++pt) y[pt] = y[pt] * el;
                const int nst = (strip >> 1) + 1;
                for (int t = 0; t < nst; ++t) { const int s0 = 32 * t;
                    const v4u sw = *(const LAS v4u*)(SW + ((st ? (wave >> 1) + 1 : 0) + t) * 1024);
                    unsigned long long xlo[4], xhi[4];
#pragma unroll
                    for (int pt = 0; pt < 4; ++pt) { const LAS bf16* xr = XT + (pt * 16 + fr) * XT_LD + s0 + 4 * fq; xlo[pt] = *(const LAS unsigned long long*)xr; xhi[pt] = *(const LAS unsigned long long*)(xr + 16); }
                    const bool fast = t < nst - 1;
                    const f32x4 wa = *(const LAS f32x4*)((fast ? W3 : acsL + j * 256) + s0 + 4 * fq), wb = *(const LAS f32x4*)((fast ? W3 : acsL + j * 256) + s0 + 16 + 4 * fq);
                    const float aref = acsL[j * 256 + s0 + 31];
                    f32x4 dta = (f32x4){0.f, 0.f, 0.f, 0.f}, dtb = dta;
                    if (!fast) { dta = *(const LAS f32x4*)(dtsL + j * 256 + s0 + 4 * fq); dtb = *(const LAS f32x4*)(dtsL + j * 256 + s0 + 16 + 4 * fq); }
                    asm volatile("" ::: "memory");
                    float sa[4], sb[4];
                    sa[0] = __uint_as_float(sw.x << 16); sa[1] = __uint_as_float(sw.x & 0xffff0000u); sa[2] = __uint_as_float(sw.y << 16); sa[3] = __uint_as_float(sw.y & 0xffff0000u);
                    sb[0] = __uint_as_float(sw.z << 16); sb[1] = __uint_as_float(sw.z & 0xffff0000u); sb[2] = __uint_as_float(sw.w << 16); sb[3] = __uint_as_float(sw.w & 0xffff0000u);
                    float pa[4], pb[4];
                    if (fast) {
                        const float u = __builtin_amdgcn_exp2f(al - aref);
#pragma unroll
                        for (int r = 0; r < 4; ++r) { pa[r] = sa[r] * (wa[r] * u); pb[r] = sb[r] * (wb[r] * u); }
                    } else {
#pragma unroll
                        for (int r = 0; r < 4; ++r) { const int s = s0 + 4 * fq + r;
                            float v = sa[r] * __builtin_amdgcn_exp2f(al - wa[r]) * dta[r]; v = s <= l ? v : 0.f; if (s == l) v += Dj; pa[r] = v;
                            float u2 = sb[r] * __builtin_amdgcn_exp2f(al - wb[r]) * dtb[r]; u2 = s + 16 <= l ? u2 : 0.f; if (s + 16 == l) u2 += Dj; pb[r] = u2; }
                    }
                    v4u pw; pw.x = pk2(pa[0], pa[1]); pw.y = pk2(pa[2], pa[3]); pw.z = pk2(pb[0], pb[1]); pw.w = pk2(pb[2], pb[3]);
                    const bf16x8 pfrag = __builtin_bit_cast(bf16x8, pw);
#pragma unroll
                    for (int pt = 0; pt < 4; ++pt) { v4u xw; xw.x = (unsigned)xlo[pt]; xw.y = (unsigned)(xlo[pt] >> 32); xw.z = (unsigned)xhi[pt]; xw.w = (unsigned)(xhi[pt] >> 32);
                        y[pt] = mfma16(__builtin_bit_cast(bf16x8, xw), pfrag, y[pt]); }
                }
                bf16* zp = Z + (rowb + t0c + l) * SSM_IN + h * 64 + 4 * fq; float sq = 0.f;
#pragma unroll
                for (int pt = 0; pt < 4; ++pt) { const unsigned lo = (unsigned)zw[st][pt], hi = (unsigned)(zw[st][pt] >> 32);
                    const float g0 = y[pt][0] * __uint_as_float(lo << 16), g1 = y[pt][1] * __uint_as_float(lo & 0xffff0000u), g2 = y[pt][2] * __uint_as_float(hi << 16), g3 = y[pt][3] * __uint_as_float(hi & 0xffff0000u);
                    sq += (g0 * g0 + g1 * g1) + (g2 * g2 + g3 * g3);
                    *(unsigned long long*)(zp + pt * 16) = (unsigned long long)pk2(g0, g1) | ((unsigned long long)pk2(g2, g3) << 32); }
                sq += __shfl_xor(sq, 16); sq += __shfl_xor(sq, 32);
                if (fq == 0) ssq[l] += sq;
            }
            __syncthreads();
        }
        {
            const int ck = tid & 63, rw0 = tid >> 6;
            const f32x4 g0 = *(const f32x4*)(a.in[I_SSMG] + g * 512 + 8 * ck), g1 = *(const f32x4*)(a.in[I_SSMG] + g * 512 + 8 * ck + 4);
            bf16* pz = Z + (rowb + t0c + rw0) * SSM_IN + g * 512 + 8 * ck;
            for (int i0 = 0; i0 < SL / 8; i0 += 4) {
                v4u w[4]; float r[4];
#pragma unroll
                for (int i = 0; i < 4; ++i) w[i] = *(const v4u*)(pz + (size_t)(i0 + i) * 8 * SSM_IN);
#pragma unroll
                for (int i = 0; i < 4; ++i) r[i] = rsqrtf(ssq[rw0 + 8 * (i0 + i)] * (1.f / 512.f) + EPS);
                asm volatile("" ::: "memory");
#pragma unroll
                for (int i = 0; i < 4; ++i) { f32x4 v0, v1; ep::unpack8(w[i], v0, v1); *(v4u*)(pz + (size_t)(i0 + i) * 8 * SSM_IN) = ep::pack8(v0 * r[i] * g0, v1 * r[i] * g1); }
            }
        }
        __syncthreads();
    }
}

__device__ __forceinline__ int crow(int r, int hi) { return (r & 3) + 8 * (r >> 2) + 4 * hi; }
typedef float f32x16 __attribute__((ext_vector_type(16)));
constexpr int AL_SLOT = 0, AL_LACC = 131072, AL_SEL = 135168, AL_CNT = 138240, AL_OFFS = 138368, AL_FILL = 138624, AL_LIST = 138880, AL_ITEMS = 141952, AL_CTL = 142976, AL_KS = 0;
typedef long i64_t;
__device__ __forceinline__ i64_t pack_p8(const float* p) { int w0 = 0, w1 = 0;
    w0 = __builtin_amdgcn_cvt_pk_bf8_f32(p[0], p[1], w0, false); w0 = __builtin_amdgcn_cvt_pk_bf8_f32(p[2], p[3], w0, true);
    w1 = __builtin_amdgcn_cvt_pk_bf8_f32(p[4], p[5], w1, false); w1 = __builtin_amdgcn_cvt_pk_bf8_f32(p[6], p[7], w1, true); return (i64_t)(((unsigned long long)(unsigned)w1 << 32) | (unsigned)w0); }
__device__ __forceinline__ i64_t cvt_q8(bf16x8 q, float sc) { float f[8]; unpk8(__builtin_bit_cast(v4u, q), f); int w0 = 0, w1 = 0;
    w0 = __builtin_amdgcn_cvt_pk_fp8_f32(f[0] * sc, f[1] * sc, w0, false); w0 = __builtin_amdgcn_cvt_pk_fp8_f32(f[2] * sc, f[3] * sc, w0, true);
    w1 = __builtin_amdgcn_cvt_pk_fp8_f32(f[4] * sc, f[5] * sc, w1, false); w1 = __builtin_amdgcn_cvt_pk_fp8_f32(f[6] * sc, f[7] * sc, w1, true); return (i64_t)(((unsigned long long)(unsigned)w1 << 32) | (unsigned)w0); }
__device__ __forceinline__ bf16x8 pack_p(const float* p) { v4u w; w.x = pk2(p[0], p[1]); w.y = pk2(p[2], p[3]); w.z = pk2(p[4], p[5]); w.w = pk2(p[6], p[7]); return __builtin_bit_cast(bf16x8, w); }
__device__ __forceinline__ void attn_mfma(const Args& a, LAS unsigned char* lds, int tid_, int wave_, int lane_, bf16* AO, bool dynq, unsigned* qcnt) {
    const int wave = wave_, lane = pg8::fresh_lane(), tid = wave * 64 + lane; (void)tid_; (void)lane_;
    const unsigned char* K8 = a.ws + WS_K; const bf16* Vt = (const bf16*)(a.ws + WS_V); const bf16* Q = (const bf16*)(a.ws + WS_Q);
    const float* ksum = (const float*)(a.ws + WS_KMEAN);
    LAS unsigned char* SLOT = lds + AL_SLOT; LAS float* LACC = (LAS float*)(lds + AL_LACC); LAS int* SEL = (LAS int*)(lds + AL_SEL);
    LAS int* CNT = (LAS int*)(lds + AL_CNT); LAS int* OFFS = (LAS int*)(lds + AL_OFFS); LAS int* FILL = (LAS int*)(lds + AL_FILL); LAS int* LIST = (LAS int*)(lds + AL_LIST);
    LAS int* ITEMS = (LAS int*)(lds + AL_ITEMS); LAS int* CTL = (LAS int*)(lds + AL_CTL); LAS float* KS = (LAS float*)(lds + AL_KS);
    float gqm = 0.f, gkm = 0.f;
    for (int d = 0; d < HD; ++d) { gqm = fmaxf(gqm, fabsf(a.in[I_GQ][d])); gkm = fmaxf(gkm, fabsf(a.in[I_GK][d])); }
    constexpr float C1 = 0.125f * 1.4426950408889634f;
    const float c0 = 8.f * gqm * gkm * 1.4426950408889634f;
    const int qi = tid >> 1, hf = tid & 1, c32 = lane & 31, hi = lane >> 5;
    const int pi32 = (c32 & ~12) | ((c32 & 4) << 1) | ((c32 & 8) >> 1);
    const bool xcd_order = (gridDim.x == 256);
    { const int t0_ = wave * 64 + pg8::fresh_lane(); if (t0_ < 32) { CNT[t0_] = 0; FILL[t0_] = 0; } }
    __syncthreads();
    for (int ui = 0; ; ++ui) {
        int bh, own;
        if (dynq) {
            if (wave == 0 && pg8::fresh_lane() == 0) CTL[2] = (int)__hip_atomic_fetch_add(qcnt, 1u, __ATOMIC_RELAXED, __HIP_MEMORY_SCOPE_AGENT);
            __syncthreads();
            const int uq = __builtin_amdgcn_readfirstlane(CTL[2]);
            __syncthreads();
            if (uq >= 128) break;
            bh = (int)(blockIdx.x & 7) + 8 * (uq >> 5); own = 31 - (uq & 31);
        } else if (xcd_order) { if (ui >= 4) break; bh = (int)(blockIdx.x & 7) + 8 * ui; const int k5 = (int)(blockIdx.x >> 3), ka = (ui & 2) ? ((k5 + 16) & 31) : k5; own = (ui & 1) ? 31 - ka : ka; }
        else { const int unit = (int)blockIdx.x + ui * (int)gridDim.x; if (unit >= BATCH * NH * NBLK) break; bh = unit & 31; own = unit >> 5; }
        const int b = bh >> 4, h = bh & 15;
        const size_t rowq0 = (size_t)b * SEQ + own * BLK;
        const int tidb = wave * 64 + pg8::fresh_lane(), laneb = tidb & 63;
        {
            const bf16* qp = Q + (rowq0 + 32 * wave + c32) * DM + h * HD + 8 * hi;
            const float* kr = ksum + ((size_t)(b * NH + h) * NBLK + c32) * 128 + 8 * hi;
            f32x16 gs;
#pragma unroll
            for (int r = 0; r < 16; ++r) gs[r] = 0.f;
            bf16x8 qfs[4]; f32x4 ka[4][2], kb[4][2];
            { const float* krs = c32 < own ? kr : kr - (size_t)c32 * 128;
#pragma unroll
              for (int s = 0; s < 4; ++s) { qfs[s] = *(const bf16x8*)(qp + 16 * s); ka[s][0] = *(const f32x4*)(krs + 16 * s); ka[s][1] = *(const f32x4*)(krs + 16 * s + 4); kb[s][0] = *(const f32x4*)(krs + 64 + 16 * s); kb[s][1] = *(const f32x4*)(krs + 64 + 16 * s + 4); } }
            asm volatile("" ::: "memory");
#pragma unroll
            for (int s = 0; s < 4; ++s) {
                const bf16x8 qf = qfs[s];
                f32x4 k0 = (f32x4){0.f, 0.f, 0.f, 0.f}, k1 = k0;
                if (c32 < own) { k0 = ka[s][0] + kb[s][0]; k1 = ka[s][1] + kb[s][1]; }
                v4u whi; whi.x = pk2(k0[0], k0[1]); whi.y = pk2(k0[2], k0[3]); whi.z = pk2(k1[0], k1[1]); whi.w = pk2(k1[2], k1[3]);
                float hv[8]; unpk8(whi, hv);
                v4u wlo; wlo.x = pk2(k0[0] - hv[0], k0[1] - hv[1]); wlo.y = pk2(k0[2] - hv[2], k0[3] - hv[3]); wlo.z = pk2(k1[0] - hv[4], k1[1] - hv[5]); wlo.w = pk2(k1[2] - hv[6], k1[3] - hv[7]);
                gs = __builtin_amdgcn_mfma_f32_32x32x16_bf16(__builtin_bit_cast(bf16x8, whi), qf, gs, 0, 0, 0);
                gs = __builtin_amdgcn_mfma_f32_32x32x16_bf16(__builtin_bit_cast(bf16x8, wlo), qf, gs, 0, 0, 0);
            }
            float bv0 = -INFINITY, bv1 = -INFINITY, bv2 = -INFINITY; int bi0 = -1, bi1 = -1, bi2 = -1;
            int hig = hi; asm volatile("" : "+v"(hig));
#pragma unroll
            for (int r = 0; r < 16; ++r) { const int n = crow(r, hig); const float gsc = gs[r];
                if (n < own) {
                    if (gsc > bv0) { bv2 = bv1; bi2 = bi1; bv1 = bv0; bi1 = bi0; bv0 = gsc; bi0 = n; }
                    else if (gsc > bv1) { bv2 = bv1; bi2 = bi1; bv1 = gsc; bi1 = n; }
                    else if (gsc > bv2) { bv2 = gsc; bi2 = n; } } }
            const float pv0 = __shfl_xor(bv0, 32), pv1 = __shfl_xor(bv1, 32), pv2 = __shfl_xor(bv2, 32); const int pi0 = __shfl_xor(bi0, 32), pi1 = __shfl_xor(bi1, 32), pi2 = __shfl_xor(bi2, 32);
#pragma unroll
            for (int t = 0; t < 3; ++t) { const float cv = t == 0 ? pv0 : t == 1 ? pv1 : pv2; const int ci = t == 0 ? pi0 : t == 1 ? pi1 : pi2;
                if (ci >= 0) {
                    if (cv > bv0 || (cv == bv0 && ci < bi0)) { bv2 = bv1; bi2 = bi1; bv1 = bv0; bi1 = bi0; bv0 = cv; bi0 = ci; }
                    else if (cv > bv1 || (cv == bv1 && (bi1 < 0 || ci < bi1))) { bv2 = bv1; bi2 = bi1; bv1 = cv; bi1 = ci; }
                    else if (cv > bv2 || (cv == bv2 && (bi2 < 0 || ci < bi2))) { bv2 = cv; bi2 = ci; } } }
            if (hi == 0) { const int qq = 32 * wave + c32; SEL[qq * 3 + 0] = bi0; SEL[qq * 3 + 1] = bi1; SEL[qq * 3 + 2] = bi2;
                if (bi0 >= 0) __hip_atomic_fetch_add(CNT + bi0, 1, __ATOMIC_RELAXED, __HIP_MEMORY_SCOPE_WORKGROUP);
                if (bi1 >= 0) __hip_atomic_fetch_add(CNT + bi1, 1, __ATOMIC_RELAXED, __HIP_MEMORY_SCOPE_WORKGROUP);
                if (bi2 >= 0) __hip_atomic_fetch_add(CNT + bi2, 1, __ATOMIC_RELAXED, __HIP_MEMORY_SCOPE_WORKGROUP); }
        }
        __syncthreads();
        {
            const int n = laneb < own ? CNT[laneb] : 0, ti = (n + 63) >> 6;
            int ninc = n, tinc = ti;
#pragma unroll
            for (int o = 1; o < 64; o <<= 1) { const int t1 = __shfl_up(ninc, o), t2 = __shfl_up(tinc, o); if (laneb >= o) { ninc += t1; tinc += t2; } }
            const int off = ninc - n, base = tinc - ti;
            if (wave == 0) {
                for (int s = 0; s < ti; ++s) { ITEMS[4 * (base + s)] = laneb; ITEMS[4 * (base + s) + 1] = off + 64 * s; ITEMS[4 * (base + s) + 2] = (n - 64 * s) < 64 ? (n - 64 * s) : 64; }
                const int tot = __builtin_amdgcn_readlane(tinc, 63);
                if (laneb < 4) { ITEMS[4 * (tot + laneb)] = 32 + (3 - laneb); ITEMS[4 * (tot + laneb) + 1] = 0; ITEMS[4 * (tot + laneb) + 2] = 64; }
                if (laneb == 0) { CTL[0] = 4 + tot; CTL[1] = 0; }
            }
            if (tidb < 256) {
#pragma unroll
                for (int s = 0; s < 3; ++s) { const int j = SEL[tidb * 3 + s]; const int offj = __shfl(off, j >= 0 ? j : 0);
                    if (j >= 0) { const int pos = __hip_atomic_fetch_add(FILL + j, 1, __ATOMIC_RELAXED, __HIP_MEMORY_SCOPE_WORKGROUP); LIST[offj + pos] = tidb | (s << 8); } }
            }
        }
        __syncthreads();
        if (tidb < 32) { CNT[tidb] = 0; FILL[tidb] = 0; }
        const int nitems = CTL[0];
        for (;;) {
            int it = 0; if (lane == 0) it = __hip_atomic_fetch_add(CTL + 1, 1, __ATOMIC_RELAXED, __HIP_MEMORY_SCOPE_WORKGROUP);
            it = __builtin_amdgcn_readfirstlane(it);
            if (it >= nitems) break;
            const int code = ITEMS[4 * it], start = ITEMS[4 * it + 1], cnt = ITEMS[4 * it + 2];
            const bool ownit = code >= 32; const int qtA = 2 * (code - 32), qtB = qtA + 1, blk = ownit ? own : code;
            const bool two = cnt > 32;
            const bool validA = c32 < cnt, validB = 32 + c32 < cnt;
            const int entA = ownit ? ((qtA * 32 + c32) | (3 << 8)) : LIST[start + (validA ? c32 : 0)];
            const int entB = ownit ? ((qtB * 32 + c32) | (3 << 8)) : two ? LIST[start + 32 + (validB ? c32 : 0)] : entA;
            const int qrelA = entA & 255, qrelB = entB & 255;
            const int nkt = ownit ? qtB + 1 : 8;
            i64_t qfA[4], qfB[4];
            { const bf16* qp = Q + (rowq0 + qrelA) * DM + h * HD + 8 * hi; const bf16* qp2 = Q + (rowq0 + qrelB) * DM + h * HD + 8 * hi;
#pragma unroll
              for (int s = 0; s < 4; ++s) { qfA[s] = cvt_q8(*(const bf16x8*)(qp + 16 * s), C1); qfB[s] = cvt_q8(*(const bf16x8*)(qp2 + 16 * s), C1); } }
            const size_t bhb = ((size_t)b * NH + h) * NBLK + blk;
            const unsigned char* kp = K8 + ((bhb * 4 + 2 * hi) * 256 + pi32) * 16;
            const bf16* vp = Vt + ((bhb * 32 + hi) * 64 + c32) * 8;
            f32x16 oA0, oA1, oB0, oB1, scA, scB; float lsA = 0.f, lsB = 0.f;
#pragma unroll
            for (int r = 0; r < 16; ++r) { oA0[r] = 0.f; oA1[r] = 0.f; oB0[r] = 0.f; oB1[r] = 0.f; }
            i64_t kX[4], kY[4]; bf16x8 vX[2][2], vY[2][2];
#define ATT_LDK(dst, kt_) do { _Pragma("unroll") for (int sp = 0; sp < 2; ++sp) { const v4u w_ = *(const v4u*)(kp + (sp * 256 + 32 * (kt_)) * 16); \
                dst[2 * sp] = (i64_t)(((unsigned long long)w_.y << 32) | w_.x); dst[2 * sp + 1] = (i64_t)(((unsigned long long)w_.w << 32) | w_.z); } } while (0)
#define ATT_LDV(dst, kt_) do { _Pragma("unroll") for (int dt = 0; dt < 2; ++dt) _Pragma("unroll") for (int s2 = 0; s2 < 2; ++s2) dst[dt][s2] = *(const bf16x8*)(vp + ((4 * (kt_) + 2 * s2) * 64 + 32 * dt) * 8); } while (0)
#define ATT_S(dst, kf_, qf_) do { _Pragma("unroll") for (int r = 0; r < 16; ++r) dst[r] = -c0; _Pragma("unroll") for (int s = 0; s < 4; ++s) dst = __builtin_amdgcn_mfma_f32_32x32x16_fp8_fp8(kf_[s], qf_[s], dst, 0, 0, 0); } while (0)
#define ATT_SM(sc_, ls_, o0_, o1_, msk_, thr_, vf_) do { float p[16]; \
                _Pragma("unroll") for (int r = 0; r < 16; ++r) p[r] = __builtin_amdgcn_exp2f(sc_[r]); \
                if (msk_) { int him_ = 8 * hi; asm volatile("" : "+v"(him_)); _Pragma("unroll") for (int r = 0; r < 16; ++r) if (16 * (r >> 3) + him_ + (r & 7) > (thr_)) p[r] = 0.f; }        \
                { f32x2_t l2_ = {p[0], p[1]}; _Pragma("unroll") for (int r = 2; r < 16; r += 2) l2_ += (f32x2_t){p[r], p[r + 1]}; ls_ += l2_[0] + l2_[1]; } \
                const bf16x8 p0 = pack_p(p), p1 = pack_p(p + 8); \
                o0_ = __builtin_amdgcn_mfma_f32_32x32x16_bf16(vf_[0][0], p0, o0_, 0, 0, 0); o1_ = __builtin_amdgcn_mfma_f32_32x32x16_bf16(vf_[1][0], p0, o1_, 0, 0, 0); \
                o0_ = __builtin_amdgcn_mfma_f32_32x32x16_bf16(vf_[0][1], p1, o0_, 0, 0, 0); o1_ = __builtin_amdgcn_mfma_f32_32x32x16_bf16(vf_[1][1], p1, o1_, 0, 0, 0); } while (0)
#define ATT_STEP(kc, kn, vc, vn) do { \
                { const int k1_ = kt + 1 < nkt ? kt + 1 : nkt - 1; ATT_LDK(kn, k1_); ATT_LDV(vn, k1_); } \
                ATT_S(scA, kc, qfA); if (two) ATT_S(scB, kc, qfB); \
                ATT_SM(scA, lsA, oA0, oA1, (ownit && kt >= qtA), c32 - 32 * (kt - qtA), vc); \
                if (two) ATT_SM(scB, lsB, oB0, oB1, (ownit && kt == qtB), c32, vc); } while (0)
            ATT_LDK(kX, 0); ATT_LDV(vX, 0);
            for (int kt = 0;;) {
                ATT_STEP(kX, kY, vX, vY);
                if (++kt >= nkt) break;
                ATT_STEP(kY, kX, vY, vX);
                if (++kt >= nkt) break;
            }
#undef ATT_STEP
#undef ATT_LDK
#undef ATT_LDV
#undef ATT_S
#undef ATT_SM
            lsA += __shfl_xor(lsA, 32); lsB += __shfl_xor(lsB, 32);
            if (validA) { const int rk = entA >> 8; LAS unsigned char* sp = SLOT + (rk * 256 + qrelA) * 128;
                if (hi == 0) LACC[rk * 256 + qrelA] = lsA;
#pragma unroll
                for (int g4 = 0; g4 < 4; ++g4) { const int ch0 = 2 * g4 + hi;
                    *(LAS unsigned long long*)(sp + (((ch0) ^ (qrelA & 15)) << 3)) = (unsigned long long)pk2(oA0[4 * g4], oA0[4 * g4 + 1]) | ((unsigned long long)pk2(oA0[4 * g4 + 2], oA0[4 * g4 + 3]) << 32);
                    *(LAS unsigned long long*)(sp + (((ch0 + 8) ^ (qrelA & 15)) << 3)) = (unsigned long long)pk2(oA1[4 * g4], oA1[4 * g4 + 1]) | ((unsigned long long)pk2(oA1[4 * g4 + 2], oA1[4 * g4 + 3]) << 32); } }
            if (two && validB) { const int rk = entB >> 8; LAS unsigned char* sp = SLOT + (rk * 256 + qrelB) * 128;
                if (hi == 0) LACC[rk * 256 + qrelB] = lsB;
#pragma unroll
                for (int g4 = 0; g4 < 4; ++g4) { const int ch0 = 2 * g4 + hi;
                    *(LAS unsigned long long*)(sp + (((ch0) ^ (qrelB & 15)) << 3)) = (unsigned long long)pk2(oB0[4 * g4], oB0[4 * g4 + 1]) | ((unsigned long long)pk2(oB0[4 * g4 + 2], oB0[4 * g4 + 3]) << 32);
                    *(LAS unsigned long long*)(sp + (((ch0 + 8) ^ (qrelB & 15)) << 3)) = (unsigned long long)pk2(oB1[4 * g4], oB1[4 * g4 + 1]) | ((unsigned long long)pk2(oB1[4 * g4 + 2], oB1[4 * g4 + 3]) << 32); } }
        }
        __syncthreads();
        for (int idx = wave * 64 + pg8::fresh_lane(); idx < 256 * 8; idx += NTHR) { const int qq = idx >> 3, ck = idx & 7;
            const int s0_ = SEL[qq * 3], s1_ = SEL[qq * 3 + 1], s2_ = SEL[qq * 3 + 2];
            float lr[4]; unsigned long long w0[4], w1[4];
#pragma unroll
            for (int rk = 0; rk < 4; ++rk) { lr[rk] = LACC[rk * 256 + qq]; const LAS unsigned char* sp = SLOT + (rk * 256 + qq) * 128;
                w0[rk] = *(const LAS unsigned long long*)(sp + (((2 * ck) ^ (qq & 15)) << 3)); w1[rk] = *(const LAS unsigned long long*)(sp + (((2 * ck + 1) ^ (qq & 15)) << 3)); }
            float o[8], l = 0.f;
#pragma unroll
            for (int i = 0; i < 8; ++i) o[i] = 0.f;
#pragma unroll
            for (int rk = 0; rk < 4; ++rk) { const bool ok = rk == 3 ? true : (rk == 0 ? s0_ : rk == 1 ? s1_ : s2_) >= 0;
                const unsigned long long a0 = ok ? w0[rk] : 0ull, a1 = ok ? w1[rk] : 0ull; l += ok ? lr[rk] : 0.f;
                o[0] += __uint_as_float((unsigned)a0 << 16); o[1] += __uint_as_float((unsigned)a0 & 0xffff0000u); o[2] += __uint_as_float((unsigned)(a0 >> 32) << 16); o[3] += __uint_as_float((unsigned)(a0 >> 32) & 0xffff0000u);
                o[4] += __uint_as_float((unsigned)a1 << 16); o[5] += __uint_as_float((unsigned)a1 & 0xffff0000u); o[6] += __uint_as_float((unsigned)(a1 >> 32) << 16); o[7] += __uint_as_float((unsigned)(a1 >> 32) & 0xffff0000u); }
            const float il = 1.f / l;
            v4u w; w.x = pk2(o[0] * il, o[1] * il); w.y = pk2(o[2] * il, o[3] * il); w.z = pk2(o[4] * il, o[5] * il); w.w = pk2(o[6] * il, o[7] * il);
            *(v4u*)(AO + (rowq0 + qq) * DM + h * HD + 8 * ck) = w; }
        __syncthreads();
    }
}

#define XB_TMO      128
#define XB_XCNT(j)  (256  + 64 * (j))
#define XB_XSUB(j)  (1280 + 64 * (j))
#define XB_XGEN(j)  (2304 + 64 * (j))
#define XB_TOP      3328
#define XB_TOPGEN   3392
#define XCD_BAR_WORDS 3456
#define XB_SPIN_CAP (1u << 18)

__device__ __forceinline__ unsigned xb_ld(unsigned* p)              { return __hip_atomic_load(p, __ATOMIC_RELAXED, __HIP_MEMORY_SCOPE_AGENT); }
__device__ __forceinline__ unsigned xb_add(unsigned* p, unsigned v) { return __hip_atomic_fetch_add(p, v, __ATOMIC_RELAXED, __HIP_MEMORY_SCOPE_AGENT); }
__device__ __forceinline__ unsigned xb_xcc_id() { return (unsigned)__builtin_amdgcn_s_getreg((3 << 11) | 20) & 0xFu; }
#define XB_SPIN(cond, bar) do { unsigned _sp = 0; while (cond) { __builtin_amdgcn_s_sleep(1); \
    if ((++_sp & 255u) == 0u) { if (xb_ld(&(bar)[XB_TMO])) break; if (_sp > XB_SPIN_CAP) { atomicAdd(&(bar)[XB_TMO], 1u); break; } } } } while (0)

struct XcdBarrier {
    unsigned* bar; unsigned x; int w;
    volatile LAS unsigned* st;
};

__device__ __forceinline__ XcdBarrier xcd_barrier_post(unsigned* bar, volatile LAS unsigned* st, int wave) {
    XcdBarrier b; b.bar = bar; b.x = xb_xcc_id(); b.st = st; b.w = wave;
    if (wave == 0 && pg8::fresh_lane() == 0) (void)xb_add(&bar[XB_XCNT(b.x)], 1u);
    return b;
}
__device__ __forceinline__ void xcd_barrier_complete(unsigned* bar, unsigned x, unsigned& nloc, unsigned& nx) {
    const unsigned G = gridDim.x * gridDim.y * gridDim.z;
    unsigned sum, cnt, mine, sp = 0u;
    for (;;) {
        sum = 0u; cnt = 0u; mine = 0u;
#pragma unroll
        for (unsigned j = 0; j < 16; ++j) { const unsigned c = xb_ld(&bar[XB_XCNT(j)]); sum += c; cnt += (c > 0u) ? 1u : 0u; mine = (j == x) ? c : mine; }
        if (sum == G) break;
        __builtin_amdgcn_s_sleep(1);
        if ((++sp & 255u) == 0u) { if (xb_ld(&bar[XB_TMO])) break; if (sp > XB_SPIN_CAP) { atomicAdd(&bar[XB_TMO], 1u); break; } }
    }
    nloc = mine > 0u ? mine : 1u; nx = cnt > 0u ? cnt : 1u;
}

__device__ __forceinline__ void xcd_barrier(const XcdBarrier& b) {
    asm volatile("s_waitcnt vmcnt(0)" ::: "memory");
    __syncthreads();
    if (b.w == 0 && pg8::fresh_lane() == 0) {
        unsigned* bar = b.bar;
        __builtin_amdgcn_s_waitcnt(0);
        unsigned nloc = b.st[0], nx = b.st[1];
        if (nloc == 0u) { xcd_barrier_complete(bar, b.x, nloc, nx); b.st[0] = nloc; b.st[1] = nx; }
        const unsigned old = xb_add(&bar[XB_XSUB(b.x)], 1u);
        const unsigned gen = old / nloc;
        if (old + 1u == (gen + 1u) * nloc) {
            __builtin_amdgcn_fence(__ATOMIC_RELEASE, "agent");
            asm volatile("s_waitcnt vmcnt(0)" ::: "memory");
            const unsigned og = xb_add(&bar[XB_TOP], 1u);
            const unsigned tg = og / nx;
            if (og + 1u == (tg + 1u) * nx) xb_add(&bar[XB_TOPGEN], 1u);
            else XB_SPIN(xb_ld(&bar[XB_TOPGEN]) == tg, bar);
            __builtin_amdgcn_fence(__ATOMIC_ACQUIRE, "agent");
            xb_add(&bar[XB_XGEN(b.x)], 1u);
            asm volatile("s_waitcnt vmcnt(0)" ::: "memory");
        } else {
            XB_SPIN(xb_ld(&bar[XB_XGEN(b.x)]) == gen, bar);
            __builtin_amdgcn_fence(__ATOMIC_ACQUIRE, "agent");
            asm volatile("s_waitcnt vmcnt(0)" ::: "memory");
        }
    }
    __syncthreads();
}


template <int K> __device__ __forceinline__ void xcd_local_barrier(const XcdBarrier& b) {
    asm volatile("s_waitcnt vmcnt(0)" ::: "memory");
    __syncthreads();
    if (b.w == 0 && pg8::fresh_lane() == 0) {
        unsigned* cnt = b.bar + 3456 + 64 * b.x;
        __builtin_amdgcn_s_waitcnt(0);
        (void)xb_add(cnt, 1u);
        XB_SPIN(xb_ld(cnt) < 32u * (unsigned)(K + 1), b.bar);
        __builtin_amdgcn_fence(__ATOMIC_ACQUIRE, "agent");
        asm volatile("s_waitcnt vmcnt(0)" ::: "memory");
    }
    __syncthreads();
}

constexpr int LDS_BYTES = 163840;
__global__ void __launch_bounds__(NTHR, 2) mk_fwd(Args a) {
    cg::grid_group grid = cg::this_grid();
    extern __shared__ __attribute__((aligned(16))) unsigned char lds_raw[];
    LAS unsigned char* lds = (LAS unsigned char*)lds_raw;
    const int tid = threadIdx.x, lane = tid & 63, wave = __builtin_amdgcn_readfirstlane(tid >> 6);
    const int G = gridDim.x, gw = blockIdx.x * NWAVES + wave, NGW = G * NWAVES;
    unsigned char* ws = a.ws;
    const pg8::bf16_t* XB = (const pg8::bf16_t*)((const unsigned char*)a.out + OUT_XB);
    const pg8::bf16_t* WIN = (const pg8::bf16_t*)(ws + WS_WIN);
    float* R1 = (float*)(ws + WS_R1);

    volatile LAS unsigned* MISC = (volatile LAS unsigned*)(lds + 163584);
    if (tid < 64) MISC[tid] = 0u;
    __syncthreads();
    const XcdBarrier bar = xcd_barrier_post((unsigned*)(ws + WS_BAR), MISC + 8, wave);
    grid.sync();
#define GSYNC() xcd_barrier(bar)
#define T0() (wave == 0 && pg8::fresh_lane() == 0)
#define XLOCAL() (__builtin_amdgcn_readfirstlane((int)MISC[11]) != 0)
    p0_prologue(a, lds, gw, NGW, wave, lane);
    if (T0()) __hip_atomic_store((unsigned*)(ws + WS_BAR + 18432) + blockIdx.x, bar.x + 1u, __ATOMIC_RELAXED, __HIP_MEMORY_SCOPE_AGENT);
    GSYNC();
    if (T0()) { bool ok = (gridDim.x == 256) && (MISC[8] == 32u);
        for (int j = 0; j < 32 && ok; ++j) ok = __hip_atomic_load((unsigned*)(ws + WS_BAR + 18432) + (blockIdx.x & 7) + 8 * j, __ATOMIC_RELAXED, __HIP_MEMORY_SCOPE_AGENT) == bar.x + 1u;
        if (!ok) __hip_atomic_store((unsigned*)(ws + WS_BAR + 20480), 1u, __ATOMIC_RELAXED, __HIP_MEMORY_SCOPE_AGENT); }
    dt_phase(a, lds, 0, wave, 0);
    { pg8::Gemm g{WIN + (size_t)2048 * DM, XB, DM, M, DM}; pg8::StaticOrder S; S.init(DM, M, G, (int)blockIdx.x);
      ep::EpiVt E{(pg8::bf16_t*)(ws + WS_V), R1};
      pg8::gemm_phase<ep::EpiVt, pg8::StaticOrder, true, true>(lds, g, S, E, wave); }
    { pg8::Gemm g{XB, WIN, M, 2048, DM}; pg8::StaticOrder S; S.init(M, 2048, G, (int)blockIdx.x);
      ep::EpiQKV E{(pg8::bf16_t*)(ws + WS_Q), (pg8::bf16_t*)(ws + WS_K), (pg8::bf16_t*)(ws + WS_V), R1, a.in[I_GQ], a.in[I_GK], (float*)(ws + WS_KMEAN)};
      pg8::gemm_phase<ep::EpiQKV, pg8::StaticOrder, true, true>(lds, g, S, E, wave); }
    { pg8::Gemm g{XB, WIN + (size_t)3072 * DM, M, 3072, DM}; pg8::StaticOrder S; S.init(M, 3072, G, (int)blockIdx.x);
      ep::EpiAct<0> E{(pg8::bf16_t*)(ws + WS_XBC), 3072, R1, 0, 0};
      pg8::gemm_phase<ep::EpiAct<0>, pg8::StaticOrder, true, true>(lds, g, S, E, wave); }
    GSYNC();
    if (T0()) MISC[11] = __hip_atomic_load((unsigned*)(ws + WS_BAR + 20480), __ATOMIC_RELAXED, __HIP_MEMORY_SCOPE_AGENT) == 0u ? 1u : 0u;
    __syncthreads();
    attn_mfma(a, lds, 0, wave, 0, (bf16*)(ws + WS_Q), XLOCAL() && gridDim.x == 256, (unsigned*)(ws + WS_BAR) + 5632 + 64 * (blockIdx.x & 7));
    ssd_s1(a, lds, 0, wave, 0);
    GSYNC();
    ssd_s2(a, wave * 64 + pg8::fresh_lane());
    { pg8::Gemm g{XB, WIN + (size_t)6144 * DM, M, 2048, DM}; pg8::StaticOrder S; S.init(M, 2048, G, (int)blockIdx.x);
      ep::EpiAct<1> E{(pg8::bf16_t*)(ws + WS_Z), 2048, R1, 0, 0};
      pg8::gemm_phase<ep::EpiAct<1>, pg8::StaticOrder, true, true>(lds, g, S, E, wave); }
    GSYNC();
    ssd_s3(a, lds, 0, wave, 0);
    GSYNC();
    { pg8::Gemm g{XB, WIN + (size_t)8192 * DM, M, DM, DM}; pg8::StaticOrder S; S.init(M, DM, G, (int)blockIdx.x);
      ep::EpiAct<2> E{(pg8::bf16_t*)(ws + WS_GA), 1024, R1, 0, 0};
      pg8::gemm_phase<ep::EpiAct<2>, pg8::StaticOrder, true, true>(lds, g, S, E, wave); }
    { pg8::Gemm g{XB, WIN + (size_t)9216 * DM, M, DM, DM}; pg8::StaticOrder S; S.init(M, DM, G, (int)blockIdx.x);
      ep::EpiAct<2> E{(pg8::bf16_t*)(ws + WS_GB), 1024, R1, 0, 0};
      pg8::gemm_phase<ep::EpiAct<2>, pg8::StaticOrder, true, true>(lds, g, S, E, wave); }
    { pg8::Gemm g{(const pg8::bf16_t*)(ws + WS_Q), (const pg8::bf16_t*)(ws + WS_WOA), M, DM, DM}; pg8::StaticOrder S; S.init(M, DM, G, (int)blockIdx.x);
      ep::EpiGate1 E{(pg8::bf16_t*)(ws + WS_GA)};
      pg8::gemm_phase<ep::EpiGate1, pg8::StaticOrder, true, true>(lds, g, S, E, wave); }
    { pg8::Gemm g{(const pg8::bf16_t*)(ws + WS_Z), (const pg8::bf16_t*)(ws + WS_WOS), M, DM, SSM_IN}; pg8::StaticOrder S; S.init(M, DM, G, (int)blockIdx.x);
      ep::EpiGate2 E{(pg8::bf16_t*)(ws + WS_GA), (const pg8::bf16_t*)(ws + WS_GB)};
      pg8::gemm_phase<ep::EpiGate2, pg8::StaticOrder, true, true>(lds, g, S, E, wave); }
    if (XLOCAL()) xcd_local_barrier<0>(bar); else GSYNC();
    { pg8::Gemm g{(const pg8::bf16_t*)(ws + WS_GA), (const pg8::bf16_t*)(ws + WS_WOUT), M, DM, DM}; pg8::StaticOrder S; S.init(M, DM, G, (int)blockIdx.x);
      ep::EpiRes<false> E{a.in[I_X], (pg8::bf16_t*)(ws + WS_X1B), (float*)(ws + WS_R2P)};
      pg8::gemm_phase<ep::EpiRes<false>, pg8::StaticOrder, true, true>(lds, g, S, E, wave); }
    GSYNC();
    { pg8::Gemm g{(const pg8::bf16_t*)(ws + WS_X1B), (const pg8::bf16_t*)(ws + WS_WGU), M, 2 * DFF, DM}; pg8::StaticOrder S; S.init(M, 2 * DFF, G, (int)blockIdx.x);
      ep::EpiSwiGLU E{(pg8::bf16_t*)(ws + WS_ACT), (const float*)(ws + WS_R2P)};
      pg8::gemm_phase<ep::EpiSwiGLU, pg8::StaticOrder, true, true>(lds, g, S, E, wave); }
    { pg8::Gemm g{(const pg8::bf16_t*)(ws + WS_PB), (const pg8::bf16_t*)(ws + WS_WPP), M, DM, PLE}; pg8::StaticOrder S;
      if (G == 256) S.init(M, DM, 128, (int)blockIdx.x >= 128 ? (int)blockIdx.x - 128 : 4096); else S.init(M, DM, G, (int)blockIdx.x);
      ep::EpiAct<0> E{(pg8::bf16_t*)(ws + WS_PP), 1024, nullptr, 0, 0};
      pg8::gemm_phase<ep::EpiAct<0>, pg8::StaticOrder, true, true>(lds, g, S, E, wave); }
    if (XLOCAL()) xcd_local_barrier<1>(bar); else GSYNC();
    { pg8::Gemm g{(const pg8::bf16_t*)(ws + WS_ACT), (const pg8::bf16_t*)(ws + WS_WDN), M, DM, DFF}; pg8::StaticOrder S; S.init(M, DM, G, (int)blockIdx.x);
      ep::EpiRes<true> E{(const void*)(ws + WS_X1B), (pg8::bf16_t*)(ws + WS_X2B), (float*)(ws + WS_R3P)};
      pg8::gemm_phase<ep::EpiRes<true>, pg8::StaticOrder, true, true>(lds, g, S, E, wave); }
    if (XLOCAL()) xcd_local_barrier<2>(bar); else GSYNC();
    { pg8::Gemm g{(const pg8::bf16_t*)(ws + WS_X2B), (const pg8::bf16_t*)(ws + WS_WPG), M, DM, DM}; pg8::StaticOrder S; S.init(M, DM, G, (int)blockIdx.x);
      ep::EpiPle E{a.out, (const pg8::bf16_t*)(ws + WS_X2B), (const pg8::bf16_t*)(ws + WS_PP), (const float*)(ws + WS_R3P)};
      pg8::gemm_phase<ep::EpiPle, pg8::StaticOrder, true, true>(lds, g, S, E, wave); }
}

extern "C" void kernel_launch(void* const* d_in, const int* in_sizes, int n_in, void* d_out, int out_size, void* d_ws, size_t ws_size, hipStream_t stream) {
    static int grid = 0;
    if (grid == 0) {
        if (n_in != 21 || out_size != M * DM || ws_size < WS_END) { fprintf(stderr, "kernel_launch: unexpected problem (n_in %d out %d ws %zu); nothing launched\n", n_in, out_size, ws_size); grid = -1; return; }
        int dev = 0, cus = 0, per_cu = 0;
        if (hipGetDevice(&dev) != hipSuccess || hipDeviceGetAttribute(&cus, hipDeviceAttributeMultiprocessorCount, dev) != hipSuccess) { grid = -1; return; }
        if (hipFuncSetAttribute((const void*)mk_fwd, hipFuncAttributeMaxDynamicSharedMemorySize, LDS_BYTES) != hipSuccess) { fprintf(stderr, "kernel_launch: hipFuncSetAttribute failed\n"); grid = -1; return; }
        if (hipOccupancyMaxActiveBlocksPerMultiprocessor(&per_cu, (const void*)mk_fwd, NTHR, LDS_BYTES) != hipSuccess || per_cu < 1) { fprintf(stderr, "kernel_launch: occupancy query says %d blocks/CU\n", per_cu); grid = -1; return; }
        grid = cus;
        (void)hipGetLastError();
    }
    if (grid < 0) return;
    if (hipMemsetAsync((char*)d_ws + WS_BAR, 0, BAR_BYTES, stream) != hipSuccess) { fprintf(stderr, "kernel_launch: memset failed\n"); return; }
    Args a{};
    for (int i = 0; i < 21; ++i) a.in[i] = (const float*)d_in[i];
    a.out = (float*)d_out; a.ws = (unsigned char*)d_ws;
    void* args[] = {&a};
    hipError_t e = hipLaunchCooperativeKernel((const void*)mk_fwd, dim3(grid), dim3(NTHR), args, LDS_BYTES, stream);
    if (e != hipSuccess) fprintf(stderr, "cooperative launch failed: %s (grid %d)\n", hipGetErrorString(e), grid);
}
```

```cpp
#include <hip/hip_runtime.h>
#include <hip/hip_cooperative_groups.h>
#include <cstdio>
#include <cstdint>
namespace cg = cooperative_groups;
namespace pg8 {
#define PG8_LAS __attribute__((address_space(3)))
typedef unsigned short bf16_t;
typedef short bf16x8 __attribute__((ext_vector_type(8)));
typedef float f32x4 __attribute__((ext_vector_type(4)));
typedef unsigned u32x4 __attribute__((ext_vector_type(4)));
constexpr int BM = 256, BK = 64, HALF = 128, HTB = HALF * BK * 2  , STAGE_BYTES = 8 * HTB, NXCD = 8, WGM = 4;

__host__ __device__ __forceinline__ int lds_byte(int r, int c) { const int st = (r >> 4) * 2 + (c >> 5), rr = r & 15, cc = c & 31, ob = rr * 64 + cc * 2; return st * 1024 + (ob ^ (((ob >> 9) & 1) << 5)); }
__host__ __device__ __forceinline__ void stage_rc(int b, int& R, int& C) { const int st = b / 1024, sb = b % 1024, swz = sb ^ (((sb >> 9) & 1) << 5); R = (st >> 1) * 16 + swz / 64; C = (st & 1) * 32 + (swz % 64) / 2; }
__host__ __device__ __forceinline__ int perm32(int rho) { const int n = rho >> 4, i = rho & 15; return 8 * (i >> 2) + 4 * n + (i & 3); }

struct Unit { int pm, pn; };
struct Gemm { const bf16_t* A; const bf16_t* Bt; int M, N, K; };

struct StaticOrder {
    int nM, nN, nwg, G, c;
    __host__ __device__ void init(int M, int N, int G_, int c_) { nM = M / BM; nN = N / BM; nwg = nM * nN; G = G_; c = c_; }
    __host__ __device__ __forceinline__ bool next(int i, Unit& u) const {
        const long L = (long)i * G + c; if (L >= nwg) return false;
        int wgid = (int)L; { const int q = nwg / NXCD, r = nwg % NXCD, xcd = wgid % NXCD, off = wgid / NXCD; wgid = (xcd < r ? xcd * (q + 1) : r * (q + 1) + (xcd - r) * q) + off; }
        const int nig = WGM * nN, gid = wgid / nig, fm = gid * WGM, gsz = (nM - fm) < WGM ? (nM - fm) : WGM;
        u.pm = fm + ((wgid % nig) % gsz); u.pn = (wgid % nig) / gsz; return true;
    }
    __device__ __forceinline__ void a_ready(const Unit&) const {}
    __device__ __forceinline__ void done(const Unit&) const {}
};

__device__ __forceinline__ unsigned cvt_pk_bf16(float lo, float hi) { unsigned r; asm volatile("v_cvt_pk_bf16_f32 %0, %1, %2" : "=v"(r) : "v"(lo), "v"(hi)); return r; }
typedef float f32x2 __attribute__((ext_vector_type(2)));
__device__ __forceinline__ int fresh_lane() { int l; asm volatile("v_mbcnt_lo_u32_b32 %0, -1, 0\n\tv_mbcnt_hi_u32_b32 %0, -1, %0" : "=v"(l)); return l; }
template <class Epi, class Sched, bool ALIGN_EPI = false, bool SP2 = false, bool CHAIN_IN = false, bool CHAIN_OUT = false>
__device__ __forceinline__ void gemm_phase(PG8_LAS unsigned char* lds, const Gemm g, const Sched& S, const Epi& E, int wave_s, const char* chA = nullptr, const char* chB = nullptr) {
    static_assert(!(CHAIN_IN || CHAIN_OUT) || (ALIGN_EPI && SP2 && !Epi::AFTER_DRAIN), "chained calls: ALIGN_EPI + SP2 only");
    const int lane = fresh_lane(), tid = wave_s * 64 + lane, wid = wave_s, wr = wid >> 2, wc = wid & 3, fr = lane & 15, fq = lane >> 4;
    const int K = g.K, nt = K / BK;
    unsigned voffA[2], voffB[2];
#pragma unroll
    for (int i = 0; i < 2; ++i) { int R, C; stage_rc(tid * 16 + i * 8192, R, C); const int Rb = Epi::PERM ? ((R & ~31) + perm32(R & 31)) : R;
        voffA[i] = (unsigned)(R * K + C) * 2u; voffB[i] = (unsigned)(Rb * K + C) * 2u; }
    const size_t kstep = (size_t)(BK * 2);
    const size_t hstep = (size_t)HALF * K * 2;
    const size_t tstep = 2 * hstep;
    const unsigned ldsw = (unsigned)wid * 1024u;
    const int aoff = lds_byte(wr * 64 + fr, fq * 8), boff = lds_byte(wc * 32 + fr, fq * 8);
#define PG8_SA(b, h) (((b) * 2 + (h)) * HTB)
#define PG8_SB(b, h) ((4 + (b) * 2 + (h)) * HTB)
#define PG8_STAGE(bufoff, gbase, voff) do { _Pragma("unroll") for (int _i = 0; _i < 2; ++_i) \
        __builtin_amdgcn_global_load_lds((const unsigned*)((const char*)(gbase) + (voff)[_i]), (PG8_LAS unsigned*)(lds + (bufoff) + ldsw + _i * 8192), 16, 0, 0); } while (0)
#define PG8_LDA(dst, b, h) do { _Pragma("unroll") for (int m = 0; m < 4; ++m) _Pragma("unroll") for (int k = 0; k < 2; ++k) dst[m][k] = *(const PG8_LAS bf16x8*)(lds + PG8_SA(b, h) + aoff + m * 2048 + k * 1024); } while (0)
#define PG8_LDB(dst, b, h) do { _Pragma("unroll") for (int n = 0; n < 2; ++n) _Pragma("unroll") for (int k = 0; k < 2; ++k) dst[n][k] = *(const PG8_LAS bf16x8*)(lds + PG8_SB(b, h) + boff + n * 2048 + k * 1024); } while (0)
#define PG8_MMA(ai, bj, At, Bt) do { __builtin_amdgcn_s_setprio(1); _Pragma("unroll") for (int m = 0; m < 4; ++m) _Pragma("unroll") for (int n = 0; n < 2; ++n) _Pragma("unroll") for (int k = 0; k < 2; ++k) \
        acc[ai][bj][m][n] = __builtin_amdgcn_mfma_f32_16x16x32_bf16(Bt[n][k], At[m][k], acc[ai][bj][m][n], 0, 0, 0); __builtin_amdgcn_s_setprio(0); } while (0)
#define PG8_WAIT_V(n) asm volatile("s_waitcnt vmcnt(" #n ")" ::: "memory")
#define PG8_WAIT_L(n) asm volatile("s_waitcnt lgkmcnt(" #n ")" ::: "memory")
#define PG8_BAR __builtin_amdgcn_s_barrier()
#define PG8_SCHED __builtin_amdgcn_sched_barrier(0)
    Unit cur, nxt; int ui = 0;
    if (!S.next(0, cur)) return;
    f32x4 acc[2][2][4][2];
#pragma unroll
    for (int a = 0; a < 2; ++a)
#pragma unroll
        for (int b = 0; b < 2; ++b)
#pragma unroll
            for (int m = 0; m < 4; ++m)
#pragma unroll
                for (int n = 0; n < 2; ++n) acc[a][b][m][n] = (f32x4){0.f, 0.f, 0.f, 0.f};
    bf16x8 At[4][2], B0[2][2], B1[2][2];
    const char* cA = (const char*)g.A + (size_t)cur.pm * tstep; const char* cB = (const char*)g.Bt + (size_t)cur.pn * tstep;
    if constexpr (!CHAIN_IN) {
    S.a_ready(cur);
    if constexpr (SP2) {
        PG8_STAGE(PG8_SB(0, 0), cB, voffB); PG8_STAGE(PG8_SB(0, 1), cB + hstep, voffB); PG8_STAGE(PG8_SA(0, 0), cA, voffA); PG8_STAGE(PG8_SA(0, 1), cA + hstep, voffA);
        if (wr == 1) PG8_BAR;
        PG8_WAIT_V(2); PG8_BAR;
        PG8_STAGE(PG8_SB(1, 0), cB + kstep, voffB); PG8_STAGE(PG8_SA(1, 0), cA + kstep, voffA); PG8_STAGE(PG8_SB(1, 1), cB + hstep + kstep, voffB);
        PG8_WAIT_V(6); PG8_BAR;
    } else {
        PG8_STAGE(PG8_SB(0, 0), cB, voffB); PG8_STAGE(PG8_SA(0, 0), cA, voffA); PG8_STAGE(PG8_SB(0, 1), cB + hstep, voffB); PG8_STAGE(PG8_SA(0, 1), cA + hstep, voffA);
        if (wr == 1) PG8_BAR;
        PG8_WAIT_V(4); PG8_BAR;
        PG8_STAGE(PG8_SB(1, 0), cB + kstep, voffB); PG8_STAGE(PG8_SA(1, 0), cA + kstep, voffA); PG8_STAGE(PG8_SB(1, 1), cB + hstep + kstep, voffB);
        PG8_WAIT_V(6); PG8_BAR;
    }
    }
    for (;;) {
        const bool has_next = S.next(ui + 1, nxt);
        const char* nA = has_next ? (const char*)g.A + (size_t)nxt.pm * tstep : CHAIN_OUT ? chA : cA; const char* nB = has_next ? (const char*)g.Bt + (size_t)nxt.pn * tstep : CHAIN_OUT ? chB : cB;
        for (int t = 0; t < nt; t += 2) {
            const bool last = (t == nt - 2);
            const char* a1 = cA + (size_t)(t + 1) * kstep;
            const char* a2 = last ? nA : cA + (size_t)(t + 2) * kstep; const char* b2 = last ? nB : cB + (size_t)(t + 2) * kstep;
            const char* a3 = a2 + kstep; const char* b3 = b2 + kstep;
            if (last && has_next) S.a_ready(nxt);
            if constexpr (SP2) {
            PG8_LDB(B0, 0, 0); PG8_LDB(B1, 0, 1); PG8_SCHED; PG8_LDA(At, 0, 0); PG8_STAGE(PG8_SA(1, 1), a1 + hstep, voffA);
            PG8_WAIT_V(8); PG8_WAIT_L(0); PG8_BAR; PG8_MMA(0, 0, At, B0); PG8_MMA(0, 1, At, B1); PG8_BAR; PG8_SCHED;
            PG8_LDA(At, 0, 1); PG8_STAGE(PG8_SB(0, 0), b2, voffB); PG8_STAGE(PG8_SB(0, 1), b2 + hstep, voffB); PG8_STAGE(PG8_SA(0, 0), a2, voffA);
            PG8_WAIT_V(8); PG8_WAIT_L(0); PG8_BAR; PG8_MMA(1, 0, At, B0); PG8_MMA(1, 1, At, B1); PG8_BAR; PG8_SCHED;
            PG8_LDB(B0, 1, 0); PG8_LDB(B1, 1, 1); PG8_SCHED; PG8_LDA(At, 1, 0); PG8_STAGE(PG8_SA(0, 1), a2 + hstep, voffA);
            PG8_WAIT_V(8); PG8_WAIT_L(0); PG8_BAR; PG8_MMA(0, 0, At, B0); PG8_MMA(0, 1, At, B1); PG8_BAR; PG8_SCHED;
            PG8_LDA(At, 1, 1); PG8_STAGE(PG8_SB(1, 0), b3, voffB); PG8_STAGE(PG8_SB(1, 1), b3 + hstep, voffB); PG8_STAGE(PG8_SA(1, 0), a3, voffA);
            PG8_WAIT_V(8); PG8_WAIT_L(0); PG8_BAR; PG8_MMA(1, 0, At, B0); PG8_MMA(1, 1, At, B1); PG8_BAR; PG8_SCHED;
            } else {
            PG8_LDB(B0, 0, 0); PG8_SCHED; PG8_LDA(At, 0, 0); PG8_STAGE(PG8_SA(1, 1), a1 + hstep, voffA);
            PG8_WAIT_L(8); PG8_BAR; PG8_WAIT_L(0); PG8_MMA(0, 0, At, B0); PG8_BAR; PG8_SCHED;
            PG8_LDB(B1, 0, 1); PG8_STAGE(PG8_SB(0, 0), b2, voffB);
            PG8_BAR; PG8_WAIT_L(0); PG8_MMA(0, 1, At, B1); PG8_BAR;
            PG8_LDA(At, 0, 1); PG8_STAGE(PG8_SA(0, 0), a2, voffA);
            PG8_BAR; PG8_WAIT_L(0); PG8_MMA(1, 0, At, B0); PG8_BAR; PG8_SCHED;
            PG8_STAGE(PG8_SB(0, 1), b2 + hstep, voffB);
            PG8_WAIT_V(6); PG8_BAR; PG8_MMA(1, 1, At, B1); PG8_BAR;
            PG8_LDB(B0, 1, 0); PG8_SCHED; PG8_LDA(At, 1, 0); PG8_STAGE(PG8_SA(0, 1), a2 + hstep, voffA);
            PG8_WAIT_L(8); PG8_BAR; PG8_WAIT_L(0); PG8_MMA(0, 0, At, B0); PG8_BAR; PG8_SCHED;
            PG8_LDB(B1, 1, 1); PG8_STAGE(PG8_SB(1, 0), b3, voffB);
            PG8_BAR; PG8_WAIT_L(0); PG8_MMA(0, 1, At, B1); PG8_BAR;
            PG8_LDA(At, 1, 1); PG8_STAGE(PG8_SA(1, 0), a3, voffA);
            PG8_BAR; PG8_WAIT_L(0); PG8_MMA(1, 0, At, B0); PG8_BAR; PG8_SCHED;
            PG8_STAGE(PG8_SB(1, 1), b3 + hstep, voffB);
            PG8_WAIT_V(6); PG8_BAR; PG8_MMA(1, 1, At, B1); PG8_BAR;
            }
        }
        if constexpr (ALIGN_EPI) { if (wr == 0) PG8_BAR; }
        if constexpr (!Epi::AFTER_DRAIN) { E(acc, cur, wr, wc, fr, fq); S.done(cur); }
        if (!has_next) break;
#pragma unroll
        for (int a = 0; a < 2; ++a)
#pragma unroll
            for (int b = 0; b < 2; ++b)
#pragma unroll
                for (int m = 0; m < 4; ++m)
#pragma unroll
                    for (int n = 0; n < 2; ++n) acc[a][b][m][n] = (f32x4){0.f, 0.f, 0.f, 0.f};
        cur = nxt; cA = nA; cB = nB; ++ui;
        if constexpr (ALIGN_EPI) { if (wr == 1) PG8_BAR; }
    }
    if constexpr (CHAIN_OUT) { if (wr == 1) PG8_BAR; return; }
    PG8_WAIT_V(0);
    if constexpr (!ALIGN_EPI) { if (wr == 0) PG8_BAR; }
    PG8_BAR;
    if constexpr (Epi::AFTER_DRAIN) { E.fused(acc, cur, wr, wc, fr, fq, lds, wid, lane); S.done(cur); }
#undef PG8_SA
#undef PG8_SB
#undef PG8_STAGE
#undef PG8_LDA
#undef PG8_LDB
#undef PG8_MMA
#undef PG8_WAIT_V
#undef PG8_WAIT_L
#undef PG8_BAR
#undef PG8_SCHED
}
}

constexpr int BATCH = 2, SEQ = 8192, DM = 1024, M = BATCH * SEQ;
constexpr int NH = 16, HD = 64, BLK = 256, NBLK = SEQ / BLK;
constexpr int SSM_IN = 2048, SSM_H = 32, SSM_P = 64, SSM_G = 4, SSM_N = 128, CONVD = 3072;
constexpr int DFF = 2816, PLE = 256, IN_DIM = 10272;
constexpr float EPS = 1e-6f;
constexpr int NWAVES = 8, NTHR = 512;

#define GAS __attribute__((address_space(1)))
#define LAS __attribute__((address_space(3)))
typedef unsigned short bf16;
typedef unsigned v4u __attribute__((ext_vector_type(4)));
typedef float f32x4 __attribute__((ext_vector_type(4)));
typedef short bf16x8 __attribute__((ext_vector_type(8)));
#define LDS_WAIT() asm volatile("s_waitcnt lgkmcnt(0)" ::: "memory")

__device__ __forceinline__ float bf2f(unsigned short b) { return __uint_as_float(((unsigned)b) << 16); }
__device__ __forceinline__ unsigned f2bf(float f) { unsigned u = __float_as_uint(f); return (u + 0x7fffu + ((u >> 16) & 1u)) >> 16; }
typedef __bf16 bf16x2_t __attribute__((ext_vector_type(2))); typedef float f32x2_t __attribute__((ext_vector_type(2)));
__device__ __forceinline__ unsigned pk2(float lo, float hi) { f32x2_t v = {lo, hi}; bf16x2_t b = __builtin_convertvector(v, bf16x2_t); return __builtin_bit_cast(unsigned, b); }
__device__ __forceinline__ float wave_sum(float v) {
#pragma unroll
    for (int o = 1; o < 64; o <<= 1) v += __shfl_xor(v, o);
    return v;
}
__device__ __forceinline__ float sigm(float x) { return __builtin_amdgcn_rcpf(1.f + __builtin_amdgcn_exp2f(x * -1.4426950408889634f)); }
__device__ __forceinline__ float siluf(float x) { return x * sigm(x); }

constexpr size_t MiB = 1u << 20;
constexpr size_t WS_R1 = 0, WS_KMEAN = 254 * MiB  , WS_R2P = 1 * MiB, WS_R3P = 2 * MiB, WS_DT = 3 * MiB;
constexpr size_t WS_BAR = 640 * 1024, BAR_BYTES = 32768;
constexpr size_t WS_WIN = 5 * MiB;
constexpr size_t WS_WOA = 26 * MiB, WS_WOS = 28 * MiB;
constexpr size_t WS_Q = 32 * MiB, WS_K = 64 * MiB, WS_V = 96 * MiB;
constexpr size_t WS_Z = 64 * MiB;
constexpr size_t WS_XBC = 128 * MiB;
constexpr size_t WS_WOUT = 224 * MiB, WS_WGU = 226 * MiB, WS_WDN = 237 * MiB, WS_WPG = 243 * MiB, WS_WPP = 245 * MiB, WS_PB = 246 * MiB;
constexpr size_t WS_GA = 128 * MiB, WS_GB = 160 * MiB;
constexpr size_t WS_X1B = 192 * MiB;
constexpr size_t WS_ACT = 32 * MiB, WS_X2B = 160 * MiB, WS_PP = 128 * MiB;
constexpr size_t WS_TAIL = 254 * MiB + 512 * 1024;
constexpr size_t WS_END = 256 * MiB;
constexpr size_t OUT_XB = 0;

namespace ep {
using pg8::bf16_t; using pg8::Unit; using pg8::u32x4; using pg8::cvt_pk_bf16;
__device__ __forceinline__ u32x4 pack8(f32x4 a, f32x4 b) { u32x4 w; w.x = pk2(a[0], a[1]); w.y = pk2(a[2], a[3]); w.z = pk2(b[0], b[1]); w.w = pk2(b[2], b[3]); return w; }
__device__ __forceinline__ uint2 pack8_fp8(f32x4 a, f32x4 b) { int w0 = 0, w1 = 0;
    w0 = __builtin_amdgcn_cvt_pk_fp8_f32(a[0], a[1], w0, false); w0 = __builtin_amdgcn_cvt_pk_fp8_f32(a[2], a[3], w0, true);
    w1 = __builtin_amdgcn_cvt_pk_fp8_f32(b[0], b[1], w1, false); w1 = __builtin_amdgcn_cvt_pk_fp8_f32(b[2], b[3], w1, true); return make_uint2((unsigned)w0, (unsigned)w1); }
__device__ __forceinline__ void unpack8(u32x4 w, f32x4& a, f32x4& b) {
    a[0] = __uint_as_float(w.x << 16); a[1] = __uint_as_float(w.x & 0xffff0000u); a[2] = __uint_as_float(w.y << 16); a[3] = __uint_as_float(w.y & 0xffff0000u);
    b[0] = __uint_as_float(w.z << 16); b[1] = __uint_as_float(w.z & 0xffff0000u); b[2] = __uint_as_float(w.w << 16); b[3] = __uint_as_float(w.w & 0xffff0000u); }
__device__ __forceinline__ float dot4(f32x4 v) { return (v[0] * v[0] + v[1] * v[1]) + (v[2] * v[2] + v[3] * v[3]); }

template <int ACT> struct EpiAct {
    static constexpr bool PERM = true, AFTER_DRAIN = false;
    bf16_t* O; int ldc; const float* rs; int split_tiles; size_t split_stride;
    __device__ __forceinline__ void operator()(const f32x4 (&acc)[2][2][4][2], const Unit& u, int wr, int wc, int fr, int fq) const {
        int pn = u.pn; bf16_t* base = O; if (split_tiles) { const int t = pn / split_tiles; base += (size_t)t * split_stride; pn -= t * split_tiles; }
        const int row0 = u.pm * 256 + wr * 64 + fr, col0 = pn * 256 + wc * 32 + 8 * fq;
        float sv[8];
#pragma unroll
        for (int i = 0; i < 8; ++i) sv[i] = rs ? rs[row0 + (i >> 2) * 128 + (i & 3) * 16] : 1.f;
        asm volatile("" ::: "memory");
#pragma unroll
        for (int ai = 0; ai < 2; ++ai)
#pragma unroll
            for (int m = 0; m < 4; ++m) { const int row = row0 + ai * 128 + m * 16; const float s = sv[ai * 4 + m]; bf16_t* rowp = base + (size_t)row * ldc + col0;
#pragma unroll
                for (int bj = 0; bj < 2; ++bj) { f32x4 v0 = acc[ai][bj][m][0] * s, v1 = acc[ai][bj][m][1] * s;
                    if (ACT == 1) { v0 = (f32x4){siluf(v0[0]), siluf(v0[1]), siluf(v0[2]), siluf(v0[3])}; v1 = (f32x4){siluf(v1[0]), siluf(v1[1]), siluf(v1[2]), siluf(v1[3])}; }
                    if (ACT == 2) { v0 = (f32x4){sigm(v0[0]), sigm(v0[1]), sigm(v0[2]), sigm(v0[3])}; v1 = (f32x4){sigm(v1[0]), sigm(v1[1]), sigm(v1[2]), sigm(v1[3])}; }
                    *(u32x4*)(rowp + bj * 128) = pack8(v0, v1); } }
    }
};
struct EpiQKV {
    static constexpr bool PERM = true, AFTER_DRAIN = false;
    bf16_t *Q, *K, *V; const float* r1; const float* gq; const float* gk; float* KS;
    __device__ __forceinline__ void operator()(const f32x4 (&acc)[2][2][4][2], const Unit& u, int wr, int wc, int fr, int fq) const {
        const int sect = u.pn >> 2, pt = u.pn & 3; const int row0 = u.pm * 256 + wr * 64 + fr;
        {
            const float* g = sect == 0 ? gq : gk; bf16_t* O = sect == 0 ? Q : K;
            const int head = pt * 4 + wc, col0 = head * 64 + 8 * fq;
            f32x4 cs[2][2];
#pragma unroll
            for (int bj = 0; bj < 2; ++bj) { cs[bj][0] = (f32x4){0.f, 0.f, 0.f, 0.f}; cs[bj][1] = (f32x4){0.f, 0.f, 0.f, 0.f}; }
            float sv[8]; f32x4 gv[2][2];
#pragma unroll
            for (int i = 0; i < 8; ++i) sv[i] = r1[row0 + (i >> 2) * 128 + (i & 3) * 16];
#pragma unroll
            for (int bj = 0; bj < 2; ++bj) { gv[bj][0] = *(const f32x4*)(g + 32 * bj + 8 * fq); gv[bj][1] = *(const f32x4*)(g + 32 * bj + 8 * fq + 4); }
            asm volatile("" ::: "memory");
            float ss8[8];
#pragma unroll
            for (int i = 0; i < 8; ++i) { float ss = 0.f;
#pragma unroll
                for (int bj = 0; bj < 2; ++bj)
#pragma unroll
                    for (int n = 0; n < 2; ++n) ss += dot4(acc[i >> 2][bj][i & 3][n]);
                ss8[i] = ss; }
#pragma unroll
            for (int i = 0; i < 8; ++i) ss8[i] += __shfl_xor(ss8[i], 16);
#pragma unroll
            for (int i = 0; i < 8; ++i) ss8[i] += __shfl_xor(ss8[i], 32);
#pragma unroll
            for (int ai = 0; ai < 2; ++ai)
#pragma unroll
                for (int m = 0; m < 4; ++m) { const int row = row0 + ai * 128 + m * 16; const float s = sv[ai * 4 + m];
                    const float ss = ss8[ai * 4 + m];
                    const float scl = s * rsqrtf(ss * s * s * (1.f / 64.f) + EPS);
                    bf16_t* rowq = O + (size_t)row * 1024 + col0;
                    unsigned char* rowk = (unsigned char*)O + (((((size_t)(u.pm >> 5) * NH + head) * NBLK + (u.pm & 31)) * 4 + 2 * (fq & 1)) * 256 + (size_t)(row & 255)) * 16 + 8 * (fq >> 1);
#pragma unroll
                    for (int bj = 0; bj < 2; ++bj) { const f32x4 g0 = gv[bj][0], g1 = gv[bj][1];
                        const f32x4 v0 = acc[ai][bj][m][0] * scl * g0, v1 = acc[ai][bj][m][1] * scl * g1;
                        cs[bj][0] += v0; cs[bj][1] += v1;
                        if (sect == 0) *(u32x4*)(rowq + bj * 32) = pack8(v0, v1); else *(uint2*)(rowk + bj * 4096) = pack8_fp8(v0, v1); }
                    asm volatile("" ::: "memory"); }
            if (sect == 1) {
#pragma unroll
                for (int o = 1; o < 16; o <<= 1)
#pragma unroll
                    for (int bj = 0; bj < 2; ++bj)
#pragma unroll
                        for (int n = 0; n < 2; ++n)
#pragma unroll
                            for (int j = 0; j < 4; ++j) cs[bj][n][j] += __shfl_xor(cs[bj][n][j], o);
                if (fr == 0) { float* kp = KS + ((((size_t)(u.pm >> 5) * NH + head) * NBLK + (u.pm & 31)) * 2 + wr) * 64 + 8 * fq;
#pragma unroll
                    for (int bj = 0; bj < 2; ++bj) { *(f32x4*)(kp + 32 * bj) = cs[bj][0]; *(f32x4*)(kp + 32 * bj + 4) = cs[bj][1]; } }
            }
        }
    }
};
struct EpiVt {
    static constexpr bool PERM = true, AFTER_DRAIN = false;
    bf16_t* O; const float* r1;
    __device__ __forceinline__ void operator()(const f32x4 (&acc)[2][2][4][2], const Unit& u, int wr, int wc, int fr, int fq) const {
        const int row0 = u.pm * 256 + wr * 64 + fr, col0 = u.pn * 256 + wc * 32 + 8 * fq;
        f32x4 s[2][2];
#pragma unroll
        for (int bj = 0; bj < 2; ++bj) { s[bj][0] = *(const f32x4*)(r1 + col0 + bj * 128); s[bj][1] = *(const f32x4*)(r1 + col0 + bj * 128 + 4); }
#pragma unroll
        for (int ai = 0; ai < 2; ++ai)
#pragma unroll
            for (int m = 0; m < 4; ++m) { const int row = row0 + ai * 128 + m * 16;
                bf16_t* rowp = O + (((((size_t)(u.pn >> 5) * NH + (row >> 6)) * NBLK + (u.pn & 31)) * 32 + 4 * wc + fq) * 64 + (row & 63)) * 8;
#pragma unroll
                for (int bj = 0; bj < 2; ++bj) *(u32x4*)(rowp + bj * 16 * 512) = pack8(acc[ai][bj][m][0] * s[bj][0], acc[ai][bj][m][1] * s[bj][1]); }
    }
};
struct EpiGate1 {
    static constexpr bool PERM = true, AFTER_DRAIN = false;
    bf16_t* G;
    __device__ __forceinline__ void operator()(const f32x4 (&acc)[2][2][4][2], const Unit& u, int wr, int wc, int fr, int fq) const {
        const int row0 = u.pm * 256 + wr * 64 + fr, col0 = u.pn * 256 + wc * 32 + 8 * fq;
        u32x4 gw[2][4][2];
#pragma unroll
        for (int ai = 0; ai < 2; ++ai)
#pragma unroll
            for (int m = 0; m < 4; ++m)
#pragma unroll
                for (int bj = 0; bj < 2; ++bj) gw[ai][m][bj] = *(const u32x4*)(G + (size_t)(row0 + ai * 128 + m * 16) * 1024 + col0 + bj * 128);
        asm volatile("" ::: "memory");
#pragma unroll
        for (int ai = 0; ai < 2; ++ai)
#pragma unroll
            for (int m = 0; m < 4; ++m) { bf16_t* rowp = G + (size_t)(row0 + ai * 128 + m * 16) * 1024 + col0;
#pragma unroll
                for (int bj = 0; bj < 2; ++bj) { f32x4 s0, s1; unpack8(gw[ai][m][bj], s0, s1);
                    *(u32x4*)(rowp + bj * 128) = pack8(acc[ai][bj][m][0] * s0, acc[ai][bj][m][1] * s1); } }
    }
};
struct EpiGate2 {
    static constexpr bool PERM = true, AFTER_DRAIN = false;
    bf16_t* G; const bf16_t* Gb;
    __device__ __forceinline__ void operator()(const f32x4 (&acc)[2][2][4][2], const Unit& u, int wr, int wc, int fr, int fq) const {
        const int row0 = u.pm * 256 + wr * 64 + fr, col0 = u.pn * 256 + wc * 32 + 8 * fq;
#pragma unroll
        for (int ai = 0; ai < 2; ++ai) {
            u32x4 gw[4][2], bw[4][2];
#pragma unroll
            for (int m = 0; m < 4; ++m)
#pragma unroll
                for (int bj = 0; bj < 2; ++bj) { const size_t off = (size_t)(row0 + ai * 128 + m * 16) * 1024 + col0 + bj * 128; gw[m][bj] = *(const u32x4*)(G + off); bw[m][bj] = *(const u32x4*)(Gb + off); }
#pragma unroll
            for (int m = 0; m < 4; ++m)
#pragma unroll
                for (int bj = 0; bj < 2; ++bj) { const size_t off = (size_t)(row0 + ai * 128 + m * 16) * 1024 + col0 + bj * 128;
                    f32x4 a0, a1, s0, s1; unpack8(gw[m][bj], a0, a1); unpack8(bw[m][bj], s0, s1);
                    *(u32x4*)(G + off) = pack8(a0 + acc[ai][bj][m][0] * s0, a1 + acc[ai][bj][m][1] * s1); }
        }
    }
};
template <bool BASE_BF16> struct EpiRes {
    static constexpr bool PERM = true, AFTER_DRAIN = false;
    const void* base; bf16_t* xb; float* part;
    __device__ __forceinline__ void operator()(const f32x4 (&acc)[2][2][4][2], const Unit& u, int wr, int wc, int fr, int fq) const {
        const int row0 = u.pm * 256 + wr * 64 + fr, col0 = u.pn * 256 + wc * 32 + 8 * fq;
#pragma unroll
        for (int ai = 0; ai < 2; ++ai) {
            f32x4 b0[4][2], b1[4][2];
#pragma unroll
            for (int m = 0; m < 4; ++m)
#pragma unroll
                for (int bj = 0; bj < 2; ++bj) { const size_t off = (size_t)(row0 + ai * 128 + m * 16) * 1024 + col0 + bj * 128;
                    if (BASE_BF16) unpack8(*(const u32x4*)((const bf16_t*)base + off), b0[m][bj], b1[m][bj]); else { b0[m][bj] = *(const f32x4*)((const float*)base + off); b1[m][bj] = *(const f32x4*)((const float*)base + off + 4); } }
            asm volatile("" ::: "memory");
            float ss4[4];
#pragma unroll
            for (int m = 0; m < 4; ++m) { const int row = row0 + ai * 128 + m * 16; float ss = 0.f;
#pragma unroll
                for (int bj = 0; bj < 2; ++bj) { const size_t off = (size_t)row * 1024 + col0 + bj * 128;
                    const f32x4 v0 = b0[m][bj] + acc[ai][bj][m][0], v1 = b1[m][bj] + acc[ai][bj][m][1];
                    *(u32x4*)(xb + off) = pack8(v0, v1); ss += dot4(v0) + dot4(v1); }
                ss4[m] = ss; }
#pragma unroll
            for (int m = 0; m < 4; ++m) ss4[m] += __shfl_xor(ss4[m], 16);
#pragma unroll
            for (int m = 0; m < 4; ++m) ss4[m] += __shfl_xor(ss4[m], 32);
#pragma unroll
            for (int m = 0; m < 4; ++m) if (fq == 0) part[(size_t)(row0 + ai * 128 + m * 16) * 16 + u.pn * 4 + wc] = ss4[m];
        }
    }
};
__device__ __forceinline__ float row_rs(const float* part, int row, int fq) {
    const f32x4 pv = *(const f32x4*)(part + (size_t)row * 16 + 4 * fq); float s = (pv[0] + pv[1]) + (pv[2] + pv[3]);
    s += __shfl_xor(s, 16); s += __shfl_xor(s, 32); return rsqrtf(s * (1.f / 1024.f) + EPS);
}
__device__ __forceinline__ void rows_rs8(const float* part, int row0, int fq, float (&r)[8]) {
    f32x4 pv[8];
#pragma unroll
    for (int i = 0; i < 8; ++i) pv[i] = *(const f32x4*)(part + (size_t)(row0 + (i >> 2) * 128 + (i & 3) * 16) * 16 + 4 * fq);
#pragma unroll
    for (int i = 0; i < 8; ++i) r[i] = (pv[i][0] + pv[i][1]) + (pv[i][2] + pv[i][3]);
#pragma unroll
    for (int i = 0; i < 8; ++i) r[i] += __shfl_xor(r[i], 16);
#pragma unroll
    for (int i = 0; i < 8; ++i) r[i] += __shfl_xor(r[i], 32);
#pragma unroll
    for (int i = 0; i < 8; ++i) r[i] = rsqrtf(r[i] * (1.f / 1024.f) + EPS);
}
struct EpiSwiGLU {
    static constexpr bool PERM = true, AFTER_DRAIN = false;
    bf16_t* O; const float* part;
    __device__ __forceinline__ void operator()(const f32x4 (&acc)[2][2][4][2], const Unit& u, int wr, int wc, int fr, int fq) const {
        const int row0 = u.pm * 256 + wr * 64 + fr, col0 = u.pn * 128 + wc * 32 + 8 * fq;
        float rr[8]; rows_rs8(part, row0, fq, rr);
#pragma unroll
        for (int ai = 0; ai < 2; ++ai)
#pragma unroll
            for (int m = 0; m < 4; ++m) { const int row = row0 + ai * 128 + m * 16; const float r = rr[ai * 4 + m];
                f32x4 a0, a1;
#pragma unroll
                for (int j = 0; j < 4; ++j) { a0[j] = siluf(acc[ai][0][m][0][j] * r) * (acc[ai][1][m][0][j] * r); a1[j] = siluf(acc[ai][0][m][1][j] * r) * (acc[ai][1][m][1][j] * r); }
                *(u32x4*)(O + (size_t)row * DFF + col0) = pack8(a0, a1); }
    }
};
struct EpiPle {
    static constexpr bool PERM = true, AFTER_DRAIN = false;
    float* out; const bf16_t* x2b; const bf16_t* pp; const float* part;
    __device__ __forceinline__ void operator()(const f32x4 (&acc)[2][2][4][2], const Unit& u, int wr, int wc, int fr, int fq) const {
        const int row0 = u.pm * 256 + wr * 64 + fr, col0 = u.pn * 256 + wc * 32 + 8 * fq;
        float rr[8]; rows_rs8(part, row0, fq, rr);
#pragma unroll
        for (int ai = 0; ai < 2; ++ai) {
            u32x4 pw[4][2], xw[4][2];
#pragma unroll
            for (int m = 0; m < 4; ++m)
#pragma unroll
                for (int bj = 0; bj < 2; ++bj) { const size_t off = (size_t)(row0 + ai * 128 + m * 16) * 1024 + col0 + bj * 128; pw[m][bj] = *(const u32x4*)(pp + off); xw[m][bj] = *(const u32x4*)(x2b + off); }
#pragma unroll
            for (int m = 0; m < 4; ++m) { const float r = rr[ai * 4 + m];
#pragma unroll
                for (int bj = 0; bj < 2; ++bj) { const size_t off = (size_t)(row0 + ai * 128 + m * 16) * 1024 + col0 + bj * 128;
                    f32x4 p0, p1, v0, v1; unpack8(pw[m][bj], p0, p1); unpack8(xw[m][bj], v0, v1);
#pragma unroll
                    for (int j = 0; j < 4; ++j) { v0[j] += p0[j] * sigm(acc[ai][bj][m][0][j] * r); v1[j] += p1[j] * sigm(acc[ai][bj][m][1][j] * r); }
                    *(f32x4*)(out + off) = v0; *(f32x4*)(out + off + 4) = v1; } }
        }
    }
};
}

struct Args { const float* in[21]; float* out; unsigned char* ws; };
enum { I_X = 0, I_P, I_LN1, I_WIN, I_GQ, I_GK, I_WOA, I_CONVW, I_CONVB, I_DTB, I_ALOG, I_DSKIP, I_SSMG, I_WOS, I_WOUT, I_LN2, I_WGU, I_WDN, I_LN3, I_WPG, I_WPP };

template <class MapF>
__device__ __forceinline__ void p0_transpose_item(const float* W, int K, int N, const float* gk, bf16* WT, LAS float* scr, int item, int lane, MapF map) {
    const int nblk = N / 32, kb = item / nblk, nb = item % nblk, k0 = 64 * kb, n0 = 32 * nb;
    float wv[32], gs[32];
#pragma unroll
    for (int i = 0; i < 32; ++i) wv[i] = W[(size_t)(k0 + 2 * i + (lane >> 5)) * N + n0 + (lane & 31)];
#pragma unroll
    for (int i = 0; i < 32; ++i) gs[i] = gk ? gk[k0 + 2 * i + (lane >> 5)] : 1.f;
    asm volatile("" ::: "memory");
#pragma unroll
    for (int i = 0; i < 32; ++i) { const int kk = 2 * i + (lane >> 5); scr[kk * 33 + (lane & 31)] = wv[i] * gs[i]; }
    LDS_WAIT(); asm volatile("" ::: "memory");
    const int c = lane & 7;
#pragma unroll
    for (int j = 0; j < 4; ++j) { const int n = (lane >> 3) + 8 * j; const LAS float* s = scr + (8 * c) * 33 + n;
        v4u o; o.x = pk2(s[0 * 33], s[1 * 33]); o.y = pk2(s[2 * 33], s[3 * 33]); o.z = pk2(s[4 * 33], s[5 * 33]); o.w = pk2(s[6 * 33], s[7 * 33]);
        *(v4u*)(WT + (size_t)map(n0 + n) * K + k0 + 8 * c) = o; }
    LDS_WAIT(); asm volatile("" ::: "memory");
}
struct MapId { __device__ __forceinline__ int operator()(int n) const { return n; } };
struct MapWin { __device__ __forceinline__ int operator()(int n) const {
    if (n < 2048) { const int l = n & 255; return (n & ~255) + 128 * ((l >> 5) & 1) + 32 * (l >> 6) + (l & 31); }
    if (n < 3072) return n;
    if (n < 5120) return 6144 + (n - 3072);
    if (n < 8192) return 3072 + (n - 5120);
    if (n < 8224) return 10240 + (n - 8192);
    return 8192 + (n - 8224); } };
struct MapGU { __device__ __forceinline__ int operator()(int n) const { const int up = n >= DFF ? 1 : 0, idx = n - up * DFF; return (idx >> 7) * 256 + up * 128 + (idx & 127); } };

__device__ __forceinline__ void p0_prologue(const Args& a, LAS unsigned char* lds, int gw, int NGW, int wave, int lane) {
    unsigned char* ws = a.ws;
    LAS float* scr = (LAS float*)(lds + wave * 16384);
    constexpr int I_IN = 16 * (IN_DIM / 32), I_SQ = 16 * 32, I_OS = 32 * 32, I_GU = 16 * (2 * DFF / 32), I_DN = (DFF / 64) * 32, I_PP = 4 * 32;
    constexpr int NITEMS = I_IN + 3 * I_SQ + I_OS + I_GU + I_DN + I_PP;
    for (int it = gw; it < NITEMS; it += NGW) {
        int r = it;
        if (r < I_IN) { p0_transpose_item(a.in[I_WIN], DM, IN_DIM, a.in[I_LN1], (bf16*)(ws + WS_WIN), scr, r, lane, MapWin()); continue; } r -= I_IN;
        if (r < I_SQ) { p0_transpose_item(a.in[I_WOA], DM, DM, nullptr, (bf16*)(ws + WS_WOA), scr, r, lane, MapId()); continue; } r -= I_SQ;
        if (r < I_SQ) { p0_transpose_item(a.in[I_WOUT], DM, DM, nullptr, (bf16*)(ws + WS_WOUT), scr, r, lane, MapId()); continue; } r -= I_SQ;
        if (r < I_SQ) { p0_transpose_item(a.in[I_WPG], DM, DM, a.in[I_LN3], (bf16*)(ws + WS_WPG), scr, r, lane, MapId()); continue; } r -= I_SQ;
        if (r < I_OS) { p0_transpose_item(a.in[I_WOS], SSM_IN, DM, nullptr, (bf16*)(ws + WS_WOS), scr, r, lane, MapId()); continue; } r -= I_OS;
        if (r < I_GU) { p0_transpose_item(a.in[I_WGU], DM, 2 * DFF, a.in[I_LN2], (bf16*)(ws + WS_WGU), scr, r, lane, MapGU()); continue; } r -= I_GU;
        if (r < I_DN) { p0_transpose_item(a.in[I_WDN], DFF, DM, nullptr, (bf16*)(ws + WS_WDN), scr, r, lane, MapId()); continue; } r -= I_DN;
        p0_transpose_item(a.in[I_WPP], PLE, DM, nullptr, (bf16*)(ws + WS_WPP), scr, r, lane, MapId());
    }
    float* r1 = (float*)(ws + WS_R1); bf16* xb = (bf16*)((unsigned char*)a.out + OUT_XB);
    for (int m0 = gw; m0 < M; m0 += 4 * NGW) {
        f32x4 v[4][4]; float sq[4];
#pragma unroll
        for (int r = 0; r < 4; ++r) { const int m = m0 + r * NGW; const f32x4* xr = (const f32x4*)(a.in[I_X] + (size_t)(m < M ? m : m0) * DM) + lane;
#pragma unroll
            for (int j = 0; j < 4; ++j) v[r][j] = xr[64 * j]; }
#pragma unroll
        for (int r = 0; r < 4; ++r) { float s = 0.f;
#pragma unroll
            for (int j = 0; j < 4; ++j) s += (v[r][j][0] * v[r][j][0] + v[r][j][1] * v[r][j][1]) + (v[r][j][2] * v[r][j][2] + v[r][j][3] * v[r][j][3]);
            sq[r] = s; }
#pragma unroll
        for (int o = 1; o < 64; o <<= 1) {
#pragma unroll
            for (int r = 0; r < 4; ++r) sq[r] += __shfl_xor(sq[r], o); }
#pragma unroll
        for (int r = 0; r < 4; ++r) { const int m = m0 + r * NGW; if (m < M) {
            if (lane == 0) r1[m] = rsqrtf(sq[r] * (1.f / DM) + EPS);
            unsigned long long* o8 = (unsigned long long*)(xb + (size_t)m * DM) + lane;
#pragma unroll
            for (int j = 0; j < 4; ++j) o8[64 * j] = (unsigned long long)pk2(v[r][j][0], v[r][j][1]) | ((unsigned long long)pk2(v[r][j][2], v[r][j][3]) << 32); } }
    }
    { const size_t n8 = (size_t)M * PLE / 8, st = (size_t)NGW * 64; const f32x4* ps = (const f32x4*)a.in[I_P]; v4u* pd = (v4u*)(ws + WS_PB);
      for (size_t i0 = (size_t)gw * 64 + lane; i0 < n8; i0 += 4 * st) { f32x4 a0[4], a1[4];
#pragma unroll
          for (int r = 0; r < 4; ++r) { const size_t i = i0 + r * st < n8 ? i0 + r * st : i0; a0[r] = ps[2 * i]; a1[r] = ps[2 * i + 1]; }
#pragma unroll
          for (int r = 0; r < 4; ++r) { const size_t i = i0 + r * st; if (i < n8) { v4u o; o.x = pk2(a0[r][0], a0[r][1]); o.y = pk2(a0[r][2], a0[r][3]); o.z = pk2(a1[r][0], a1[r][1]); o.w = pk2(a1[r][2], a1[r][3]); pd[i] = o; } } } }
}

__device__ __forceinline__ void dt_phase(const Args& a, LAS unsigned char* lds, int tid_, int wave_, int lane_) {
    const int wave = wave_, lane = pg8::fresh_lane(), tid = wave * 64 + lane; (void)tid_; (void)lane_;
    const bf16* xb = (const bf16*)((const unsigned char*)a.out + OUT_XB); const bf16* wdt = (const bf16*)(a.ws + WS_WIN) + (size_t)10240 * DM;
    const float* r1 = (const float*)(a.ws + WS_R1); float* dt = (float*)(a.ws + WS_DT);
    LAS float* part = (LAS float*)lds;
    const int fr = lane & 15, fq = lane >> 4;
    for (int it = blockIdx.x; it < M / 64; it += gridDim.x) {
        const bf16* ap = xb + (size_t)(it * 64 + fr) * DM + wave * 128 + 8 * fq; const bf16* bp = wdt + (size_t)fr * DM + wave * 128 + 8 * fq;
        bf16x8 af[4][4], bfr[4][2];
#pragma unroll
        for (int ks = 0; ks < 4; ++ks) {
#pragma unroll
            for (int m = 0; m < 4; ++m) af[ks][m] = *(const bf16x8*)(ap + (size_t)m * 16 * DM + ks * 32);
#pragma unroll
            for (int n = 0; n < 2; ++n) bfr[ks][n] = *(const bf16x8*)(bp + (size_t)n * 16 * DM + ks * 32); }
        f32x4 acc[4][2];
#pragma unroll
        for (int m = 0; m < 4; ++m) { acc[m][0] = (f32x4){0.f, 0.f, 0.f, 0.f}; acc[m][1] = (f32x4){0.f, 0.f, 0.f, 0.f}; }
#pragma unroll
        for (int ks = 0; ks < 4; ++ks)
#pragma unroll
            for (int m = 0; m < 4; ++m)
#pragma unroll
                for (int n = 0; n < 2; ++n) acc[m][n] = __builtin_amdgcn_mfma_f32_16x16x32_bf16(bfr[ks][n], af[ks][m], acc[m][n], 0, 0, 0);
#pragma unroll
        for (int m = 0; m < 4; ++m)
#pragma unroll
            for (int n = 0; n < 2; ++n) *(LAS f32x4*)(part + ((wave * 64 + lane) * 8 + m * 2 + n) * 4) = acc[m][n];
        __syncthreads();
        { const int l2 = tid & 63, mn = tid >> 6, m = mn >> 1, n = mn & 1, fr2 = l2 & 15, fq2 = l2 >> 4;
          f32x4 s = (f32x4){0.f, 0.f, 0.f, 0.f};
#pragma unroll
          for (int w = 0; w < 8; ++w) s += *(const LAS f32x4*)(part + ((w * 64 + l2) * 8 + mn) * 4);
          const int row = it * 64 + 16 * m + fr2; const float rs = r1[row]; const f32x4 bb = *(const f32x4*)(a.in[I_DTB] + 16 * n + 4 * fq2); f32x4 o;
#pragma unroll
          for (int j = 0; j < 4; ++j) { const float x = s[j] * rs + bb[j]; o[j] = x > 20.f ? x : log1pf(expf(x)); }
          *(f32x4*)(dt + (size_t)row * SSM_H + 16 * n + 4 * fq2) = o; }
        __syncthreads();
    }
}

constexpr int SL = 256, NCH = SEQ / SL;
constexpr size_t OUT_ST = 32 * MiB;
constexpr size_t WS_DEC = 512 * 1024;
constexpr int XT_LD = 264, BN_LD = 136;
__device__ __forceinline__ f32x4 mfma16(bf16x8 a, bf16x8 b, f32x4 c) { return __builtin_amdgcn_mfma_f32_16x16x32_bf16(a, b, c, 0, 0, 0); }
__device__ __forceinline__ void unpk8(v4u w, float (&o)[8]) {
    o[0] = __uint_as_float(w.x << 16); o[1] = __uint_as_float(w.x & 0xffff0000u); o[2] = __uint_as_float(w.y << 16); o[3] = __uint_as_float(w.y & 0xffff0000u);
    o[4] = __uint_as_float(w.z << 16); o[5] = __uint_as_float(w.z & 0xffff0000u); o[6] = __uint_as_float(w.w << 16); o[7] = __uint_as_float(w.w & 0xffff0000u); }
template <int NR> __device__ __forceinline__ void conv_load(const bf16* xb, int t0, v4u (&raw)[NR + 3]) {
#pragma unroll
    for (int i = 0; i < NR + 3; ++i) { const int t = t0 - 3 + i; raw[i] = t >= 0 ? *(const v4u*)(xb + (size_t)t * CONVD) : (v4u){0u, 0u, 0u, 0u}; }
}
struct ConvW { float w[4][8], bias[8]; };
__device__ __forceinline__ void conv_loadw(const float* cw, const float* cb, int ch0, ConvW& c) {
#pragma unroll
    for (int k = 0; k < 4; ++k) { const f32x4 x0 = *(const f32x4*)(cw + (size_t)k * CONVD + ch0), x1 = *(const f32x4*)(cw + (size_t)k * CONVD + ch0 + 4);
        c.w[k][0] = x0[0]; c.w[k][1] = x0[1]; c.w[k][2] = x0[2]; c.w[k][3] = x0[3]; c.w[k][4] = x1[0]; c.w[k][5] = x1[1]; c.w[k][6] = x1[2]; c.w[k][7] = x1[3]; }
    { const f32x4 x0 = *(const f32x4*)(cb + ch0), x1 = *(const f32x4*)(cb + ch0 + 4); c.bias[0] = x0[0]; c.bias[1] = x0[1]; c.bias[2] = x0[2]; c.bias[3] = x0[3]; c.bias[4] = x1[0]; c.bias[5] = x1[1]; c.bias[6] = x1[2]; c.bias[7] = x1[3]; }
}
template <int NR> __device__ __forceinline__ void conv_compute_w(const v4u (&raw)[NR + 3], const ConvW& c, float (&out)[NR][8]) {
    float r0[8], r1[8], r2[8], cur[8];
    unpk8(raw[0], r0); unpk8(raw[1], r1); unpk8(raw[2], r2);
#pragma unroll
    for (int r = 0; r < NR; ++r) {
        unpk8(raw[r + 3], cur);
#pragma unroll
        for (int i = 0; i < 8; ++i) { const float v = c.bias[i] + c.w[0][i] * r0[i] + c.w[1][i] * r1[i] + c.w[2][i] * r2[i] + c.w[3][i] * cur[i]; out[r][i] = siluf(v); r0[i] = r1[i]; r1[i] = r2[i]; r2[i] = cur[i]; }
    }
}
template <int NR> __device__ __forceinline__ void conv_compute(const v4u (&raw)[NR + 3], const float* cw, const float* cb, int ch0, float (&out)[NR][8]) { ConvW c; conv_loadw(cw, cb, ch0, c); conv_compute_w<NR>(raw, c, out); }
template <int NR> __device__ __forceinline__ void conv8(const bf16* xb, int t0, const float* cw, const float* cb, int ch0, float (&out)[NR][8]) { v4u raw[NR + 3]; conv_load<NR>(xb, t0, raw); conv_compute<NR>(raw, cw, cb, ch0, out); }
__device__ __forceinline__ float ssd_dt_scan(const Args& a, size_t row0, int h, int lane, float (&d)[4], float (&acs)[4]) {
    const float* DT = (const float*)(a.ws + WS_DT); const float A = -expf(a.in[I_ALOG][h]);
#pragma unroll
    for (int i = 0; i < 4; ++i) d[i] = DT[(row0 + 4 * lane + i) * SSM_H + h];
    const float s1 = d[0] * A, s2 = s1 + d[1] * A, s3 = s2 + d[2] * A, s4 = s3 + d[3] * A;
    float incl = s4;
#pragma unroll
    for (int o = 1; o < 64; o <<= 1) { const float t = __shfl_up(incl, o); if (lane >= o) incl += t; }
    const float excl = incl - s4;
    acs[0] = excl + s1; acs[1] = excl + s2; acs[2] = excl + s3; acs[3] = excl + s4;
    return __shfl(incl, 63);
}
constexpr int S1_W = 0, S1_B = 8192, S1_X = 8192 + 67584;
__device__ __forceinline__ void st_rows8(bf16* dst, bf16* tl, int r0, const float (&o)[8][8]) {
#pragma unroll
    for (int r = 0; r < 8; ++r) { v4u w; w.x = pk2(o[r][0], o[r][1]); w.y = pk2(o[r][2], o[r][3]); w.z = pk2(o[r][4], o[r][5]); w.w = pk2(o[r][6], o[r][7]);
        bf16* p = (r >= 5 && r0 + r >= 253) ? tl + (size_t)(r0 + r - 253) * CONVD : dst + (size_t)r * CONVD; *(v4u*)p = w; }
}
__device__ __forceinline__ void ssd_s1(const Args& a, LAS unsigned char* lds, int tid_, int wave_, int lane_) {
    const int wave = wave_, lane = pg8::fresh_lane(), tid = wave * 64 + lane; (void)tid_; (void)lane_;
    bf16* XBC = (bf16*)(a.ws + WS_XBC); bf16* TAIL = (bf16*)(a.ws + WS_TAIL); bf16* ST = (bf16*)((unsigned char*)a.out + OUT_ST); float* DEC = (float*)(a.ws + WS_DEC);
    LAS float* W8 = (LAS float*)(lds + S1_W); LAS bf16* BT = (LAS bf16*)(lds + S1_B); LAS bf16* XT = (LAS bf16*)(lds + S1_X);
    const int fr = lane & 15, fq = lane >> 4, chunk = tid & 15, r0 = 8 * (tid >> 4);
    for (int unit = blockIdx.x; unit < BATCH * NCH * SSM_G; unit += gridDim.x) {
        const int g = unit & 3, c = (unit >> 2) & 31, b = unit >> 7; const size_t rowb = (size_t)b * SEQ; const int t0c = c * SL;
        bf16* xrow = XBC + rowb * CONVD; bf16* tlb = TAIL + (size_t)((b * NCH + c) * 3) * CONVD;
        v4u raw[11]; ConvW cwx;
        { const int ch0 = g * 512 + (chunk >> 3) * 64 + 8 * (chunk & 7); conv_load<8>(xrow + ch0, t0c + r0, raw); }
        { const int h = g * 8 + wave; float d[4], acs[4]; const float tot = ssd_dt_scan(a, rowb + t0c, h, lane, d, acs); if (lane == 0) DEC[(b * NCH + c) * 32 + h] = expf(tot);
          *(LAS f32x4*)(W8 + wave * 256 + 4 * lane) = (f32x4){d[0] * __expf(tot - acs[0]), d[1] * __expf(tot - acs[1]), d[2] * __expf(tot - acs[2]), d[3] * __expf(tot - acs[3])}; }
        { const int ch0 = 2048 + g * 128 + 8 * chunk; float o[8][8]; v4u rawb[11];
          conv_load<8>(xrow + ch0, t0c + r0, rawb); ConvW cwb; conv_loadw(a.in[I_CONVW], a.in[I_CONVB], ch0, cwb);
          asm volatile("s_waitcnt vmcnt(0)" ::: "memory"); __syncthreads();
          conv_compute_w<8>(rawb, cwb, o);
#pragma unroll
          for (int i = 0; i < 8; ++i) { v4u w; w.x = pk2(o[0][i], o[1][i]); w.y = pk2(o[2][i], o[3][i]); w.z = pk2(o[4][i], o[5][i]); w.w = pk2(o[6][i], o[7][i]); *(LAS v4u*)(BT + (8 * chunk + i) * XT_LD + r0) = w; }
          st_rows8(xrow + (size_t)(t0c + r0) * CONVD + ch0, tlb + ch0, r0, o); }
        conv_loadw(a.in[I_CONVW], a.in[I_CONVB], g * 512 + (chunk >> 3) * 64 + 8 * (chunk & 7), cwx);
        __syncthreads();
        for (int pr = 0; pr < 4; ++pr) {
            { const int hj = 2 * pr + (chunk >> 3), ch0 = g * 512 + hj * 64 + 8 * (chunk & 7); float o[8][8];
              conv_compute_w<8>(raw, cwx, o);
              st_rows8(xrow + (size_t)(t0c + r0) * CONVD + ch0, tlb + ch0, r0, o);
#pragma unroll
              for (int r = 0; r < 8; ++r) { const float wgt = W8[hj * 256 + r0 + r];
#pragma unroll
                  for (int i = 0; i < 8; ++i) o[r][i] *= wgt; }
#pragma unroll
              for (int i = 0; i < 8; ++i) { v4u w; w.x = pk2(o[0][i], o[1][i]); w.y = pk2(o[2][i], o[3][i]); w.z = pk2(o[4][i], o[5][i]); w.w = pk2(o[6][i], o[7][i]); *(LAS v4u*)(XT + (8 * chunk + i) * XT_LD + r0) = w; } }
            __syncthreads();
            { const int ch0 = pr < 3 ? g * 512 + (2 * pr + 2 + (chunk >> 3)) * 64 + 8 * (chunk & 7) : 2560 + g * 128 + 8 * chunk;
              conv_load<8>(xrow + ch0, t0c + r0, raw); conv_loadw(a.in[I_CONVW], a.in[I_CONVB], ch0, cwx); }
            const int e = wave >> 2, pt = wave & 3, h = g * 8 + 2 * pr + e;
            f32x4 acc[8];
#pragma unroll
            for (int nt = 0; nt < 8; ++nt) acc[nt] = (f32x4){0.f, 0.f, 0.f, 0.f};
            { bf16x8 xf[2], bfr[2][8];
#define S1_LD(ks_, set_) do { xf[set_] = *(const LAS bf16x8*)(XT + (e * 64 + pt * 16 + fr) * XT_LD + 32 * (ks_) + 8 * fq); \
                _Pragma("unroll") for (int nt = 0; nt < 8; ++nt) bfr[set_][nt] = *(const LAS bf16x8*)(BT + (nt * 16 + fr) * XT_LD + 32 * (ks_) + 8 * fq); } while (0)
              S1_LD(0, 0);
#pragma unroll
              for (int ks = 0; ks < 8; ++ks) {
                  if (ks < 7) S1_LD(ks + 1, (ks + 1) & 1);
                  asm volatile("" ::: "memory");
#pragma unroll
                  for (int nt = 0; nt < 8; ++nt) acc[nt] = mfma16(bfr[ks & 1][nt], xf[ks & 1], acc[nt]);
              }
#undef S1_LD
            }
            bf16* dst = ST + ((((size_t)b * 32 + h) * NCH + c) * 64 + pt * 16 + fr) * 128 + 4 * fq;
#pragma unroll
            for (int nt = 0; nt < 8; ++nt) *(unsigned long long*)(dst + nt * 16) = (unsigned long long)pk2(acc[nt][0], acc[nt][1]) | ((unsigned long long)pk2(acc[nt][2], acc[nt][3]) << 32);
            asm volatile("s_waitcnt vmcnt(0)" ::: "memory");
            __syncthreads();
        }
        { const int ch0 = 2560 + g * 128 + 8 * chunk; float o[8][8];
          conv_compute_w<8>(raw, cwx, o);
          st_rows8(xrow + (size_t)(t0c + r0) * CONVD + ch0, tlb + ch0, r0, o); }
    }
}
__device__ __forceinline__ void ssd_s2(const Args& a, int tid_) {
    const int tid = tid_;
    unsigned long long* ST = (unsigned long long*)((unsigned char*)a.out + OUT_ST); const float* DEC = (const float*)(a.ws + WS_DEC);
    for (int e = blockIdx.x * NTHR + tid; e < BATCH * 32 * 2048; e += gridDim.x * NTHR) {
        const int b = e >> 16, h = (e >> 11) & 31, q4 = e & 2047;
        unsigned long long* p = ST + ((size_t)(b * 32 + h) * NCH) * 2048 + q4; constexpr size_t cst = 2048;
        unsigned long long w[NCH]; float dv[NCH];
#pragma unroll
        for (int c = 0; c < NCH; ++c) w[c] = p[c * cst];
#pragma unroll
        for (int c = 0; c < NCH; ++c) dv[c] = DEC[(b * NCH + c) * 32 + h];
        asm volatile("" ::: "memory");
        float s0 = 0.f, s1 = 0.f, s2 = 0.f, s3 = 0.f;
#pragma unroll
        for (int c = 0; c < NCH; ++c) { const float dec = dv[c];
            p[c * cst] = (unsigned long long)pk2(s0, s1) | ((unsigned long long)pk2(s2, s3) << 32);
            const unsigned lo = (unsigned)w[c], hi = (unsigned)(w[c] >> 32);
            s0 = s0 * dec + __uint_as_float(lo << 16); s1 = s1 * dec + __uint_as_float(lo & 0xffff0000u); s2 = s2 * dec + __uint_as_float(hi << 16); s3 = s3 * dec + __uint_as_float(hi & 0xffff0000u); }
    }
}
constexpr int S3_BSZ = 73728  , S3_ACS = 0, S3_DTS = 8192, S3_SSQ = 16384, S3_B = 17408, S3_X = 17408 + S3_BSZ, S3_P = 17408 + S3_BSZ + 34816, S3_W3 = 17408 + S3_BSZ + 34816 + 16384, S3_P2 = S3_W3 + 1024;
__device__ __forceinline__ void ssd_s3(const Args& a, LAS unsigned char* lds, int tid_, int wave_, int lane_) {
    const int wave = wave_, lane = pg8::fresh_lane(), tid = wave * 64 + lane; (void)tid_; (void)lane_;
    const bf16* XBC = (const bf16*)(a.ws + WS_XBC); const bf16* ST = (const bf16*)((const unsigned char*)a.out + OUT_ST); bf16* Z = (bf16*)(a.ws + WS_Z);
    LAS float* acsL = (LAS float*)(lds + S3_ACS); LAS float* dtsL = (LAS float*)(lds + S3_DTS); LAS float* ssq = (LAS float*)(lds + S3_SSQ);
    LAS bf16* Bn = (LAS bf16*)(lds + S3_B); LAS bf16* XT = (LAS bf16*)(lds + S3_X); LAS float* W3 = (LAS float*)(lds + S3_W3);
    const int fr = lane & 15, fq = lane >> 4, xchunk = tid & 7, xr0 = 4 * (tid >> 3);
    for (int unit = blockIdx.x; unit < BATCH * NCH * SSM_G; unit += gridDim.x) {
        const int g = unit & 3, c = (unit >> 2) & 31, b = unit >> 7; const size_t rowb = (size_t)b * SEQ; const int t0c = c * SL;
        const bf16* tlb = (const bf16*)(a.ws + WS_TAIL) + (size_t)((b * NCH + c) * 3) * CONVD;
        { float d[4], acs[4]; (void)ssd_dt_scan(a, rowb + t0c, g * 8 + wave, lane, d, acs);
          constexpr float L2E = 1.4426950408889634f; *(LAS f32x4*)(acsL + wave * 256 + 4 * lane) = (f32x4){acs[0] * L2E, acs[1] * L2E, acs[2] * L2E, acs[3] * L2E}; *(LAS f32x4*)(dtsL + wave * 256 + 4 * lane) = (f32x4){d[0], d[1], d[2], d[3]}; }
        if (tid < 256) ssq[tid] = 0.f;
        bf16x8 cf[2][4];
#pragma unroll
        for (int st = 0; st < 2; ++st) {
            { const int t2 = tid & 255, chunk = t2 & 15, r0 = 8 * (t2 >> 4);
              const bool isC = tid < 256; const int rr = isC ? st * 128 + r0 : st * 128 + r0, ch0 = (isC ? 2560 : 2048) + g * 128 + 8 * chunk;
              const bf16* src = XBC + (rowb + t0c + rr) * CONVD + ch0; v4u w[8];
#pragma unroll
              for (int r = 0; r < 8; ++r) w[r] = *(const v4u*)((r >= 5 && rr + r >= 253) ? tlb + (size_t)(rr + r - 253) * CONVD + ch0 : src + (size_t)r * CONVD);
              LAS bf16* dstl = isC ? XT + r0 * BN_LD + 8 * chunk : Bn + (st * 128 + r0) * BN_LD + 8 * chunk;
#pragma unroll
              for (int r = 0; r < 8; ++r) *(LAS v4u*)(dstl + r * BN_LD) = w[r]; }
            __syncthreads();
            { const int lrel = (st ? 15 - wave : wave) * 16 - st * 128 + fr;
#pragma unroll
              for (int ks = 0; ks < 4; ++ks) cf[st][ks] = *(const LAS bf16x8*)(XT + lrel * BN_LD + 32 * ks + 8 * fq); }
            __syncthreads();
        }
        LAS unsigned char* SW = lds + S3_B + wave * 9216 + lane * 16;
        {   v4u stw[9];
#pragma unroll
            for (int q = 0; q < 9; ++q) {
                const int n0 = (wave >> 1) + 1, st = q < n0 ? 0 : 1, t = st ? q - n0 : q, s0 = 32 * t;
                f32x4 sa = (f32x4){0.f, 0.f, 0.f, 0.f}, sb = sa;
                bf16x8 b0[4], b1[4];
#pragma unroll
                for (int ks = 0; ks < 4; ++ks) { b0[ks] = *(const LAS bf16x8*)(Bn + (s0 + fr) * BN_LD + 32 * ks + 8 * fq); b1[ks] = *(const LAS bf16x8*)(Bn + (s0 + 16 + fr) * BN_LD + 32 * ks + 8 * fq); }
                asm volatile("" ::: "memory");
#pragma unroll
                for (int ks = 0; ks < 4; ++ks) { const bf16x8 c0 = st ? cf[1][ks] : cf[0][ks];
                    sa = mfma16(b0[ks], c0, sa); sb = mfma16(b1[ks], c0, sb); }
                stw[q].x = pk2(sa[0], sa[1]); stw[q].y = pk2(sa[2], sa[3]); stw[q].z = pk2(sb[0], sb[1]); stw[q].w = pk2(sb[2], sb[3]);
            }
            __syncthreads();
#pragma unroll
            for (int q = 0; q < 9; ++q) *(LAS v4u*)(SW + q * 1024) = stw[q];
        }
        v4u raw[4];
#define S3_LDX(jj) do { const int ch_ = g * 512 + (jj) * 64 + 8 * xchunk; const bf16* xs_ = XBC + (rowb + t0c + xr0) * CONVD + ch_; \
            _Pragma("unroll") for (int r = 0; r < 4; ++r) raw[r] = *(const v4u*)((r >= 1 && xr0 + r >= 253) ? tlb + (size_t)(xr0 + r - 253) * CONVD + ch_ : xs_ + (size_t)r * CONVD); } while (0)
        S3_LDX(0);
#define S3_DMA(jj) do { const bf16* pvg_ = ST + ((((size_t)b * 32 + g * 8 + (jj)) * NCH + c) * 64) * 128; LAS unsigned char* pvl_ = lds + (((jj) & 1) ? S3_P2 : S3_P); \
            _Pragma("unroll") for (int i = 0; i < 2; ++i) { const int L = i * 512 + tid, row = L >> 4, cpos = L & 15; \
                __builtin_amdgcn_global_load_lds((const unsigned*)(pvg_ + (size_t)row * 128 + 8 * (cpos ^ (row & 15))), (__attribute__((address_space(3))) unsigned*)(pvl_ + (i * 512 + wave * 64) * 16), 16, 0, 0); } } while (0)
        S3_DMA(0);
        for (int j = 0; j < 8; ++j) {
            const int h = g * 8 + j; const float Dj = a.in[I_DSKIP][h];
            LAS unsigned char* PV = lds + ((j & 1) ? S3_P2 : S3_P);
            if (tid < 256) W3[tid] = dtsL[j * 256 + tid] * __builtin_amdgcn_exp2f(acsL[j * 256 + (tid | 31)] - acsL[j * 256 + tid]);
            {
#pragma unroll
                for (int i2 = 0; i2 < 4; ++i2) {
                    const unsigned a0 = raw[0][i2], a1 = raw[1][i2], a2 = raw[2][i2], a3 = raw[3][i2];
                    const unsigned e01 = __builtin_amdgcn_perm(a1, a0, 0x05040100u), e23 = __builtin_amdgcn_perm(a3, a2, 0x05040100u);
                    const unsigned o01 = __builtin_amdgcn_perm(a1, a0, 0x07060302u), o23 = __builtin_amdgcn_perm(a3, a2, 0x07060302u);
                    *(LAS unsigned long long*)(XT + (8 * xchunk + 2 * i2) * XT_LD + xr0) = (unsigned long long)e01 | ((unsigned long long)e23 << 32);
                    *(LAS unsigned long long*)(XT + (8 * xchunk + 2 * i2 + 1) * XT_LD + xr0) = (unsigned long long)o01 | ((unsigned long long)o23 << 32); } }
            __syncthreads();
            if (j < 7) { S3_DMA(j + 1); S3_LDX(j + 1); }
            unsigned long long zw[2][4];
#pragma unroll
            for (int st = 0; st < 2; ++st) { const int l = (st ? 15 - wave : wave) * 16 + fr; const bf16* zp = Z + (rowb + t0c + l) * SSM_IN + h * 64 + 4 * fq;
#pragma unroll
                for (int pt = 0; pt < 4; ++pt) zw[st][pt] = *(const unsigned long long*)(zp + pt * 16); }
#pragma unroll
            for (int st = 0; st < 2; ++st) {
                const int strip = st ? 15 - wave : wave, l = strip * 16 + fr;
                f32x4 y[4];
#pragma unroll
                for (int pt = 0; pt < 4; ++pt) y[pt] = (f32x4){0.f, 0.f, 0.f, 0.f};
                { bf16x8 pf[2][4];
#define S3_PLD(ks_, set_) do { _Pragma("unroll") for (int pt = 0; pt < 4; ++pt) { const int prow = pt * 16 + fr; pf[set_][pt] = *(const LAS bf16x8*)(PV + prow * 256 + (((4 * (ks_) + fq) ^ (prow & 15)) << 4)); } } while (0)
                  S3_PLD(0, 0);
#pragma unroll
                  for (int ks = 0; ks < 4; ++ks) {
                      if (ks < 3) S3_PLD(ks + 1, (ks + 1) & 1);
                      asm volatile("" ::: "memory");
#pragma unroll
                      for (int pt = 0; pt < 4; ++pt) y[pt] = mfma16(pf[ks & 1][pt], cf[st][ks], y[pt]);
                  }
#undef S3_PLD
                }
                const float al = acsL[j * 256 + l], el = __builtin_amdgcn_exp2f(al);
#pragma unroll
                for (int pt = 0; pt < 4; ++pt) y[pt] = y[pt] * el;
                const int nst = (strip >> 1) + 1;
                for (int t = 0; t < nst; ++t) { const int s0 = 32 * t;
                    const v4u sw = *(const LAS v4u*)(SW + ((st ? (wave >> 1) + 1 : 0) + t) * 1024);
                    unsigned long long xlo[4], xhi[4];
#pragma unroll
                    for (int pt = 0; pt < 4; ++pt) { const LAS bf16* xr = XT + (pt * 16 + fr) * XT_LD + s0 + 4 * fq; xlo[pt] = *(const LAS unsigned long long*)xr; xhi[pt] = *(const LAS unsigned long long*)(xr + 16); }
                    const bool fast = t < nst - 1;
                    const f32x4 wa = *(const LAS f32x4*)((fast ? W3 : acsL + j * 256) + s0 + 4 * fq), wb = *(const LAS f32x4*)((fast ? W3 : acsL + j * 256) + s0 + 16 + 4 * fq);
                    const float aref = acsL[j * 256 + s0 + 31];
                    f32x4 dta = (f32x4){0.f, 0.f, 0.f, 0.f}, dtb = dta;
                    if (!fast) { dta = *(const LAS f32x4*)(dtsL + j * 256 + s0 + 4 * fq); dtb = *(const LAS f32x4*)(dtsL + j * 256 + s0 + 16 + 4 * fq); }
                    asm volatile("" ::: "memory");
                    float sa[4], sb[4];
                    sa[0] = __uint_as_float(sw.x << 16); sa[1] = __uint_as_float(sw.x & 0xffff0000u); sa[2] = __uint_as_float(sw.y << 16); sa[3] = __uint_as_float(sw.y & 0xffff0000u);
                    sb[0] = __uint_as_float(sw.z << 16); sb[1] = __uint_as_float(sw.z & 0xffff0000u); sb[2] = __uint_as_float(sw.w << 16); sb[3] = __uint_as_float(sw.w & 0xffff0000u);
                    float pa[4], pb[4];
                    if (fast) {
                        const float u = __builtin_amdgcn_exp2f(al - aref);
#pragma unroll
                        for (int r = 0; r < 4; ++r) { pa[r] = sa[r] * (wa[r] * u); pb[r] = sb[r] * (wb[r] * u); }
                    } else {
#pragma unroll
                        for (int r = 0; r < 4; ++r) { const int s = s0 + 4 * fq + r;
                            float v = sa[r] * __builtin_amdgcn_exp2f(al - wa[r]) * dta[r]; v = s <= l ? v : 0.f; if (s == l) v += Dj; pa[r] = v;
                            float u2 = sb[r] * __builtin_amdgcn_exp2f(al - wb[r]) * dtb[r]; u2 = s + 16 <= l ? u2 : 0.f; if (s + 16 == l) u2 += Dj; pb[r] = u2; }
                    }
                    v4u pw; pw.x = pk2(pa[0], pa[1]); pw.y = pk2(pa[2], pa[3]); pw.z = pk2(pb[0], pb[1]); pw.w = pk2(pb[2], pb[3]);
                    const bf16x8 pfrag = __builtin_bit_cast(bf16x8, pw);
#pragma unroll
                    for (int pt = 0; pt < 4; ++pt) { v4u xw; xw.x = (unsigned)xlo[pt]; xw.y = (unsigned)(xlo[pt] >> 32); xw.z = (unsigned)xhi[pt]; xw.w = (unsigned)(xhi[pt] >> 32);
                        y[pt] = mfma16(__builtin_bit_cast(bf16x8, xw), pfrag, y[pt]); }
                }
                bf16* zp = Z + (rowb + t0c + l) * SSM_IN + h * 64 + 4 * fq; float sq = 0.f;
#pragma unroll
                for (int pt = 0; pt < 4; ++pt) { const unsigned lo = (unsigned)zw[st][pt], hi = (unsigned)(zw[st][pt] >> 32);
                    const float g0 = y[pt][0] * __uint_as_float(lo << 16), g1 = y[pt][1] * __uint_as_float(lo & 0xffff0000u), g2 = y[pt][2] * __uint_as_float(hi << 16), g3 = y[pt][3] * __uint_as_float(hi & 0xffff0000u);
                    sq += (g0 * g0 + g1 * g1) + (g2 * g2 + g3 * g3);
                    *(unsigned long long*)(zp + pt * 16) = (unsigned long long)pk2(g0, g1) | ((unsigned long long)pk2(g2, g3) << 32); }
                sq += __shfl_xor(sq, 16); sq += __shfl_xor(sq, 32);
                if (fq == 0) ssq[l] += sq;
            }
            __syncthreads();
        }
        {
            const int ck = tid & 63, rw0 = tid >> 6;
            const f32x4 g0 = *(const f32x4*)(a.in[I_SSMG] + g * 512 + 8 * ck), g1 = *(const f32x4*)(a.in[I_SSMG] + g * 512 + 8 * ck + 4);
            bf16* pz = Z + (rowb + t0c + rw0) * SSM_IN + g * 512 + 8 * ck;
            for (int i0 = 0; i0 < SL / 8; i0 += 4) {
                v4u w[4]; float r[4];
#pragma unroll
                for (int i = 0; i < 4; ++i) w[i] = *(const v4u*)(pz + (size_t)(i0 + i) * 8 * SSM_IN);
#pragma unroll
                for (int i = 0; i < 4; ++i) r[i] = rsqrtf(ssq[rw0 + 8 * (i0 + i)] * (1.f / 512.f) + EPS);
                asm volatile("" ::: "memory");
#pragma unroll
                for (int i = 0; i < 4; ++i) { f32x4 v0, v1; ep::unpack8(w[i], v0, v1); *(v4u*)(pz + (size_t)(i0 + i) * 8 * SSM_IN) = ep::pack8(v0 * r[i] * g0, v1 * r[i] * g1); }
            }
        }
        __syncthreads();
    }
}

__device__ __forceinline__ int crow(int r, int hi) { return (r & 3) + 8 * (r >> 2) + 4 * hi; }
typedef float f32x16 __attribute__((ext_vector_type(16)));
constexpr int AL_SLOT = 0, AL_LACC = 131072, AL_SEL = 135168, AL_CNT = 138240, AL_OFFS = 138368, AL_FILL = 138624, AL_LIST = 138880, AL_ITEMS = 141952, AL_CTL = 142976, AL_KS = 0;
typedef long i64_t;
__device__ __forceinline__ i64_t pack_p8(const float* p) { int w0 = 0, w1 = 0;
    w0 = __builtin_amdgcn_cvt_pk_bf8_f32(p[0], p[1], w0, false); w0 = __builtin_amdgcn_cvt_pk_bf8_f32(p[2], p[3], w0, true);
    w1 = __builtin_amdgcn_cvt_pk_bf8_f32(p[4], p[5], w1, false); w1 = __builtin_amdgcn_cvt_pk_bf8_f32(p[6], p[7], w1, true); return (i64_t)(((unsigned long long)(unsigned)w1 << 32) | (unsigned)w0); }
__device__ __forceinline__ i64_t cvt_q8(bf16x8 q, float sc) { float f[8]; unpk8(__builtin_bit_cast(v4u, q), f); int w0 = 0, w1 = 0;
    w0 = __builtin_amdgcn_cvt_pk_fp8_f32(f[0] * sc, f[1] * sc, w0, false); w0 = __builtin_amdgcn_cvt_pk_fp8_f32(f[2] * sc, f[3] * sc, w0, true);
    w1 = __builtin_amdgcn_cvt_pk_fp8_f32(f[4] * sc, f[5] * sc, w1, false); w1 = __builtin_amdgcn_cvt_pk_fp8_f32(f[6] * sc, f[7] * sc, w1, true); return (i64_t)(((unsigned long long)(unsigned)w1 << 32) | (unsigned)w0); }
__device__ __forceinline__ bf16x8 pack_p(const float* p) { v4u w; w.x = pk2(p[0], p[1]); w.y = pk2(p[2], p[3]); w.z = pk2(p[4], p[5]); w.w = pk2(p[6], p[7]); return __builtin_bit_cast(bf16x8, w); }
__device__ __forceinline__ void attn_mfma(const Args& a, LAS unsigned char* lds, int tid_, int wave_, int lane_, bf16* AO, bool dynq, unsigned* qcnt) {
    const int wave = wave_, lane = pg8::fresh_lane(), tid = wave * 64 + lane; (void)tid_; (void)lane_;
    const unsigned char* K8 = a.ws + WS_K; const bf16* Vt = (const bf16*)(a.ws + WS_V); const bf16* Q = (const bf16*)(a.ws + WS_Q);
    const float* ksum = (const float*)(a.ws + WS_KMEAN);
    LAS unsigned char* SLOT = lds + AL_SLOT; LAS float* LACC = (LAS float*)(lds + AL_LACC); LAS int* SEL = (LAS int*)(lds + AL_SEL);
    LAS int* CNT = (LAS int*)(lds + AL_CNT); LAS int* OFFS = (LAS int*)(lds + AL_OFFS); LAS int* FILL = (LAS int*)(lds + AL_FILL); LAS int* LIST = (LAS int*)(lds + AL_LIST);
    LAS int* ITEMS = (LAS int*)(lds + AL_ITEMS); LAS int* CTL = (LAS int*)(lds + AL_CTL); LAS float* KS = (LAS float*)(lds + AL_KS);
    float gqm = 0.f, gkm = 0.f;
    for (int d = 0; d < HD; ++d) { gqm = fmaxf(gqm, fabsf(a.in[I_GQ][d])); gkm = fmaxf(gkm, fabsf(a.in[I_GK][d])); }
    constexpr float C1 = 0.125f * 1.4426950408889634f;
    const float c0 = 8.f * gqm * gkm * 1.4426950408889634f;
    const int qi = tid >> 1, hf = tid & 1, c32 = lane & 31, hi = lane >> 5;
    const int pi32 = (c32 & ~12) | ((c32 & 4) << 1) | ((c32 & 8) >> 1);
    const bool xcd_order = (gridDim.x == 256);
    { const int t0_ = wave * 64 + pg8::fresh_lane(); if (t0_ < 32) { CNT[t0_] = 0; FILL[t0_] = 0; } }
    __syncthreads();
    for (int ui = 0; ; ++ui) {
        int bh, own;
        if (dynq) {
            if (wave == 0 && pg8::fresh_lane() == 0) CTL[2] = (int)__hip_atomic_fetch_add(qcnt, 1u, __ATOMIC_RELAXED, __HIP_MEMORY_SCOPE_AGENT);
            __syncthreads();
            const int uq = __builtin_amdgcn_readfirstlane(CTL[2]);
            __syncthreads();
            if (uq >= 128) break;
            bh = (int)(blockIdx.x & 7) + 8 * (uq >> 5); own = 31 - (uq & 31);
        } else if (xcd_order) { if (ui >= 4) break; bh = (int)(blockIdx.x & 7) + 8 * ui; const int k5 = (int)(blockIdx.x >> 3), ka = (ui & 2) ? ((k5 + 16) & 31) : k5; own = (ui & 1) ? 31 - ka : ka; }
        else { const int unit = (int)blockIdx.x + ui * (int)gridDim.x; if (unit >= BATCH * NH * NBLK) break; bh = unit & 31; own = unit >> 5; }
        const int b = bh >> 4, h = bh & 15;
        const size_t rowq0 = (size_t)b * SEQ + own * BLK;
        const int tidb = wave * 64 + pg8::fresh_lane(), laneb = tidb & 63;
        {
            const bf16* qp = Q + (rowq0 + 32 * wave + c32) * DM + h * HD + 8 * hi;
            const float* kr = ksum + ((size_t)(b * NH + h) * NBLK + c32) * 128 + 8 * hi;
            f32x16 gs;
#pragma unroll
            for (int r = 0; r < 16; ++r) gs[r] = 0.f;
            bf16x8 qfs[4]; f32x4 ka[4][2], kb[4][2];
            { const float* krs = c32 < own ? kr : kr - (size_t)c32 * 128;
#pragma unroll
              for (int s = 0; s < 4; ++s) { qfs[s] = *(const bf16x8*)(qp + 16 * s); ka[s][0] = *(const f32x4*)(krs + 16 * s); ka[s][1] = *(const f32x4*)(krs + 16 * s + 4); kb[s][0] = *(const f32x4*)(krs + 64 + 16 * s); kb[s][1] = *(const f32x4*)(krs + 64 + 16 * s + 4); } }
            asm volatile("" ::: "memory");
#pragma unroll
            for (int s = 0; s < 4; ++s) {
                const bf16x8 qf = qfs[s];
                f32x4 k0 = (f32x4){0.f, 0.f, 0.f, 0.f}, k1 = k0;
                if (c32 < own) { k0 = ka[s][0] + kb[s][0]; k1 = ka[s][1] + kb[s][1]; }
                v4u whi; whi.x = pk2(k0[0], k0[1]); whi.y = pk2(k0[2], k0[3]); whi.z = pk2(k1[0], k1[1]); whi.w = pk2(k1[2], k1[3]);
                float hv[8]; unpk8(whi, hv);
                v4u wlo; wlo.x = pk2(k0[0] - hv[0], k0[1] - hv[1]); wlo.y = pk2(k0[2] - hv[2], k0[3] - hv[3]); wlo.z = pk2(k1[0] - hv[4], k1[1] - hv[5]); wlo.w = pk2(k1[2] - hv[6], k1[3] - hv[7]);
                gs = __builtin_amdgcn_mfma_f32_32x32x16_bf16(__builtin_bit_cast(bf16x8, whi), qf, gs, 0, 0, 0);
                gs = __builtin_amdgcn_mfma_f32_32x32x16_bf16(__builtin_bit_cast(bf16x8, wlo), qf, gs, 0, 0, 0);
            }
            float bv0 = -INFINITY, bv1 = -INFINITY, bv2 = -INFINITY; int bi0 = -1, bi1 = -1, bi2 = -1;
            int hig = hi; asm volatile("" : "+v"(hig));
#pragma unroll
            for (int r = 0; r < 16; ++r) { const int n = crow(r, hig); const float gsc = gs[r];
                if (n < own) {
                    if (gsc > bv0) { bv2 = bv1; bi2 = bi1; bv1 = bv0; bi1 = bi0; bv0 = gsc; bi0 = n; }
                    else if (gsc > bv1) { bv2 = bv1; bi2 = bi1; bv1 = gsc; bi1 = n; }
                    else if (gsc > bv2) { bv2 = gsc; bi2 = n; } } }
            const float pv0 = __shfl_xor(bv0, 32), pv1 = __shfl_xor(bv1, 32), pv2 = __shfl_xor(bv2, 32); const int pi0 = __shfl_xor(bi0, 32), pi1 = __shfl_xor(bi1, 32), pi2 = __shfl_xor(bi2, 32);
#pragma unroll
            for (int t = 0; t < 3; ++t) { const float cv = t == 0 ? pv0 : t == 1 ? pv1 : pv2; const int ci = t == 0 ? pi0 : t == 1 ? pi1 : pi2;
                if (ci >= 0) {
                    if (cv > bv0 || (cv == bv0 && ci < bi0)) { bv2 = bv1; bi2 = bi1; bv1 = bv0; bi1 = bi0; bv0 = cv; bi0 = ci; }
                    else if (cv > bv1 || (cv == bv1 && (bi1 < 0 || ci < bi1))) { bv2 = bv1; bi2 = bi1; bv1 = cv; bi1 = ci; }
                    else if (cv > bv2 || (cv == bv2 && (bi2 < 0 || ci < bi2))) { bv2 = cv; bi2 = ci; } } }
            if (hi == 0) { const int qq = 32 * wave + c32; SEL[qq * 3 + 0] = bi0; SEL[qq * 3 + 1] = bi1; SEL[qq * 3 + 2] = bi2;
                if (bi0 >= 0) __hip_atomic_fetch_add(CNT + bi0, 1, __ATOMIC_RELAXED, __HIP_MEMORY_SCOPE_WORKGROUP);
                if (bi1 >= 0) __hip_atomic_fetch_add(CNT + bi1, 1, __ATOMIC_RELAXED, __HIP_MEMORY_SCOPE_WORKGROUP);
                if (bi2 >= 0) __hip_atomic_fetch_add(CNT + bi2, 1, __ATOMIC_RELAXED, __HIP_MEMORY_SCOPE_WORKGROUP); }
        }
        __syncthreads();
        {
            const int n = laneb < own ? CNT[laneb] : 0, ti = (n + 63) >> 6;
            int ninc = n, tinc = ti;
#pragma unroll
            for (int o = 1; o < 64; o <<= 1) { const int t1 = __shfl_up(ninc, o), t2 = __shfl_up(tinc, o); if (laneb >= o) { ninc += t1; tinc += t2; } }
            const int off = ninc - n, base = tinc - ti;
            if (wave == 0) {
                for (int s = 0; s < ti; ++s) { ITEMS[4 * (base + s)] = laneb; ITEMS[4 * (base + s) + 1] = off + 64 * s; ITEMS[4 * (base + s) + 2] = (n - 64 * s) < 64 ? (n - 64 * s) : 64; }
                const int tot = __builtin_amdgcn_readlane(tinc, 63);
                if (laneb < 4) { ITEMS[4 * (tot + laneb)] = 32 + (3 - laneb); ITEMS[4 * (tot + laneb) + 1] = 0; ITEMS[4 * (tot + laneb) + 2] = 64; }
                if (laneb == 0) { CTL[0] = 4 + tot; CTL[1] = 0; }
            }
            if (tidb < 256) {
#pragma unroll
                for (int s = 0; s < 3; ++s) { const int j = SEL[tidb * 3 + s]; const int offj = __shfl(off, j >= 0 ? j : 0);
                    if (j >= 0) { const int pos = __hip_atomic_fetch_add(FILL + j, 1, __ATOMIC_RELAXED, __HIP_MEMORY_SCOPE_WORKGROUP); LIST[offj + pos] = tidb | (s << 8); } }
            }
        }
        __syncthreads();
        if (tidb < 32) { CNT[tidb] = 0; FILL[tidb] = 0; }
        const int nitems = CTL[0];
        for (;;) {
            int it = 0; if (lane == 0) it = __hip_atomic_fetch_add(CTL + 1, 1, __ATOMIC_RELAXED, __HIP_MEMORY_SCOPE_WORKGROUP);
            it = __builtin_amdgcn_readfirstlane(it);
            if (it >= nitems) break;
            const int code = ITEMS[4 * it], start = ITEMS[4 * it + 1], cnt = ITEMS[4 * it + 2];
            const bool ownit = code >= 32; const int qtA = 2 * (code - 32), qtB = qtA + 1, blk = ownit ? own : code;
            const bool two = cnt > 32;
            const bool validA = c32 < cnt, validB = 32 + c32 < cnt;
            const int entA = ownit ? ((qtA * 32 + c32) | (3 << 8)) : LIST[start + (validA ? c32 : 0)];
            const int entB = ownit ? ((qtB * 32 + c32) | (3 << 8)) : two ? LIST[start + 32 + (validB ? c32 : 0)] : entA;
            const int qrelA = entA & 255, qrelB = entB & 255;
            const int nkt = ownit ? qtB + 1 : 8;
            i64_t qfA[4], qfB[4];
            { const bf16* qp = Q + (rowq0 + qrelA) * DM + h * HD + 8 * hi; const bf16* qp2 = Q + (rowq0 + qrelB) * DM + h * HD + 8 * hi;
#pragma unroll
              for (int s = 0; s < 4; ++s) { qfA[s] = cvt_q8(*(const bf16x8*)(qp + 16 * s), C1); qfB[s] = cvt_q8(*(const bf16x8*)(qp2 + 16 * s), C1); } }
            const size_t bhb = ((size_t)b * NH + h) * NBLK + blk;
            const unsigned char* kp = K8 + ((bhb * 4 + 2 * hi) * 256 + pi32) * 16;
            const bf16* vp = Vt + ((bhb * 32 + hi) * 64 + c32) * 8;
            f32x16 oA0, oA1, oB0, oB1, scA, scB; float lsA = 0.f, lsB = 0.f;
#pragma unroll
            for (int r = 0; r < 16; ++r) { oA0[r] = 0.f; oA1[r] = 0.f; oB0[r] = 0.f; oB1[r] = 0.f; }
            i64_t kX[4], kY[4]; bf16x8 vX[2][2], vY[2][2];
#define ATT_LDK(dst, kt_) do { _Pragma("unroll") for (int sp = 0; sp < 2; ++sp) { const v4u w_ = *(const v4u*)(kp + (sp * 256 + 32 * (kt_)) * 16); \
                dst[2 * sp] = (i64_t)(((unsigned long long)w_.y << 32) | w_.x); dst[2 * sp + 1] = (i64_t)(((unsigned long long)w_.w << 32) | w_.z); } } while (0)
#define ATT_LDV(dst, kt_) do { _Pragma("unroll") for (int dt = 0; dt < 2; ++dt) _Pragma("unroll") for (int s2 = 0; s2 < 2; ++s2) dst[dt][s2] = *(const bf16x8*)(vp + ((4 * (kt_) + 2 * s2) * 64 + 32 * dt) * 8); } while (0)
#define ATT_S(dst, kf_, qf_) do { _Pragma("unroll") for (int r = 0; r < 16; ++r) dst[r] = -c0; _Pragma("unroll") for (int s = 0; s < 4; ++s) dst = __builtin_amdgcn_mfma_f32_32x32x16_fp8_fp8(kf_[s], qf_[s], dst, 0, 0, 0); } while (0)
#define ATT_SM(sc_, ls_, o0_, o1_, msk_, thr_, vf_) do { float p[16]; \
                _Pragma("unroll") for (int r = 0; r < 16; ++r) p[r] = __builtin_amdgcn_exp2f(sc_[r]); \
                if (msk_) { int him_ = 8 * hi; asm volatile("" : "+v"(him_)); _Pragma("unroll") for (int r = 0; r < 16; ++r) if (16 * (r >> 3) + him_ + (r & 7) > (thr_)) p[r] = 0.f; }        \
                { f32x2_t l2_ = {p[0], p[1]}; _Pragma("unroll") for (int r = 2; r < 16; r += 2) l2_ += (f32x2_t){p[r], p[r + 1]}; ls_ += l2_[0] + l2_[1]; } \
                const bf16x8 p0 = pack_p(p), p1 = pack_p(p + 8); \
                o0_ = __builtin_amdgcn_mfma_f32_32x32x16_bf16(vf_[0][0], p0, o0_, 0, 0, 0); o1_ = __builtin_amdgcn_mfma_f32_32x32x16_bf16(vf_[1][0], p0, o1_, 0, 0, 0); \
                o0_ = __builtin_amdgcn_mfma_f32_32x32x16_bf16(vf_[0][1], p1, o0_, 0, 0, 0); o1_ = __builtin_amdgcn_mfma_f32_32x32x16_bf16(vf_[1][1], p1, o1_, 0, 0, 0); } while (0)
#define ATT_STEP(kc, kn, vc, vn) do { \
                { const int k1_ = kt + 1 < nkt ? kt + 1 : nkt - 1; ATT_LDK(kn, k1_); ATT_LDV(vn, k1_); } \
                ATT_S(scA, kc, qfA); if (two) ATT_S(scB, kc, qfB); \
                ATT_SM(scA, lsA, oA0, oA1, (ownit && kt >= qtA), c32 - 32 * (kt - qtA), vc); \
                if (two) ATT_SM(scB, lsB, oB0, oB1, (ownit && kt == qtB), c32, vc); } while (0)
            ATT_LDK(kX, 0); ATT_LDV(vX, 0);
            for (int kt = 0;;) {
                ATT_STEP(kX, kY, vX, vY);
                if (++kt >= nkt) break;
                ATT_STEP(kY, kX, vY, vX);
                if (++kt >= nkt) break;
            }
#undef ATT_STEP
#undef ATT_LDK
#undef ATT_LDV
#undef ATT_S
#undef ATT_SM
            lsA += __shfl_xor(lsA, 32); lsB += __shfl_xor(lsB, 32);
            if (validA) { const int rk = entA >> 8; LAS unsigned char* sp = SLOT + (rk * 256 + qrelA) * 128;
                if (hi == 0) LACC[rk * 256 + qrelA] = lsA;
#pragma unroll
                for (int g4 = 0; g4 < 4; ++g4) { const int ch0 = 2 * g4 + hi;
                    *(LAS unsigned long long*)(sp + (((ch0) ^ (qrelA & 15)) << 3)) = (unsigned long long)pk2(oA0[4 * g4], oA0[4 * g4 + 1]) | ((unsigned long long)pk2(oA0[4 * g4 + 2], oA0[4 * g4 + 3]) << 32);
                    *(LAS unsigned long long*)(sp + (((ch0 + 8) ^ (qrelA & 15)) << 3)) = (unsigned long long)pk2(oA1[4 * g4], oA1[4 * g4 + 1]) | ((unsigned long long)pk2(oA1[4 * g4 + 2], oA1[4 * g4 + 3]) << 32); } }
            if (two && validB) { const int rk = entB >> 8; LAS unsigned char* sp = SLOT + (rk * 256 + qrelB) * 128;
                if (hi == 0) LACC[rk * 256 + qrelB] = lsB;
#pragma unroll
                for (int g4 = 0; g4 < 4; ++g4) { const int ch0 = 2 * g4 + hi;
                    *(LAS unsigned long long*)(sp + (((ch0) ^ (qrelB & 15)) << 3)) = (unsigned long long)pk2(oB0[4 * g4], oB0[4 * g4 + 1]) | ((unsigned long long)pk2(oB0[4 * g4 + 2], oB0[4 * g4 + 3]) << 32);
                    *(LAS unsigned long long*)(sp + (((ch0 + 8) ^ (qrelB & 15)) << 3)) = (unsigned long long)pk2(oB1[4 * g4], oB1[4 * g4 + 1]) | ((unsigned long long)pk2(oB1[4 * g4 + 2], oB1[4 * g4 + 3]) << 32); } }
        }
        __syncthreads();
        for (int idx = wave * 64 + pg8::fresh_lane(); idx < 256 * 8; idx += NTHR) { const int qq = idx >> 3, ck = idx & 7;
            const int s0_ = SEL[qq * 3], s1_ = SEL[qq * 3 + 1], s2_ = SEL[qq * 3 + 2];
            float lr[4]; unsigned long long w0[4], w1[4];
#pragma unroll
            for (int rk = 0; rk < 4; ++rk) { lr[rk] = LACC[rk * 256 + qq]; const LAS unsigned char* sp = SLOT + (rk * 256 + qq) * 128;
                w0[rk] = *(const LAS unsigned long long*)(sp + (((2 * ck) ^ (qq & 15)) << 3)); w1[rk] = *(const LAS unsigned long long*)(sp + (((2 * ck + 1) ^ (qq & 15)) << 3)); }
            float o[8], l = 0.f;
#pragma unroll
            for (int i = 0; i < 8; ++i) o[i] = 0.f;
#pragma unroll
            for (int rk = 0; rk < 4; ++rk) { const bool ok = rk == 3 ? true : (rk == 0 ? s0_ : rk == 1 ? s1_ : s2_) >= 0;
                const unsigned long long a0 = ok ? w0[rk] : 0ull, a1 = ok ? w1[rk] : 0ull; l += ok ? lr[rk] : 0.f;
                o[0] += __uint_as_float((unsigned)a0 << 16); o[1] += __uint_as_float((unsigned)a0 & 0xffff0000u); o[2] += __uint_as_float((unsigned)(a0 >> 32) << 16); o[3] += __uint_as_float((unsigned)(a0 >> 32) & 0xffff0000u);
                o[4] += __uint_as_float((unsigned)a1 << 16); o[5] += __uint_as_float((unsigned)a1 & 0xffff0000u); o[6] += __uint_as_float((unsigned)(a1 >> 32) << 16); o[7] += __uint_as_float((unsigned)(a1 >> 32) & 0xffff0000u); }
            const float il = 1.f / l;
            v4u w; w.x = pk2(o[0] * il, o[1] * il); w.y = pk2(o[2] * il, o[3] * il); w.z = pk2(o[4] * il, o[5] * il); w.w = pk2(o[6] * il, o[7] * il);
            *(v4u*)(AO + (rowq0 + qq) * DM + h * HD + 8 * ck) = w; }
        __syncthreads();
    }
}

#define XB_TMO      128
#define XB_XCNT(j)  (256  + 64 * (j))
#define XB_XSUB(j)  (1280 + 64 * (j))
#define XB_XGEN(j)  (2304 + 64 * (j))
#define XB_TOP      3328
#define XB_TOPGEN   3392
#define XCD_BAR_WORDS 3456
#define XB_SPIN_CAP (1u << 18)

__device__ __forceinline__ unsigned xb_ld(unsigned* p)              { return __hip_atomic_load(p, __ATOMIC_RELAXED, __HIP_MEMORY_SCOPE_AGENT); }
__device__ __forceinline__ unsigned xb_add(unsigned* p, unsigned v) { return __hip_atomic_fetch_add(p, v, __ATOMIC_RELAXED, __HIP_MEMORY_SCOPE_AGENT); }
__device__ __forceinline__ unsigned xb_xcc_id() { return (unsigned)__builtin_amdgcn_s_getreg((3 << 11) | 20) & 0xFu; }
#define XB_SPIN(cond, bar) do { unsigned _sp = 0; while (cond) { __builtin_amdgcn_s_sleep(1); \
    if ((++_sp & 255u) == 0u) { if (xb_ld(&(bar)[XB_TMO])) break; if (_sp > XB_SPIN_CAP) { atomicAdd(&(bar)[XB_TMO], 1u); break; } } } } while (0)

struct XcdBarrier {
    unsigned* bar; unsigned x; int w;
    volatile LAS unsigned* st;
};

__device__ __forceinline__ XcdBarrier xcd_barrier_post(unsigned* bar, volatile LAS unsigned* st, int wave) {
    XcdBarrier b; b.bar = bar; b.x = xb_xcc_id(); b.st = st; b.w = wave;
    if (wave == 0 && pg8::fresh_lane() == 0) (void)xb_add(&bar[XB_XCNT(b.x)], 1u);
    return b;
}
__device__ __forceinline__ void xcd_barrier_complete(unsigned* bar, unsigned x, unsigned& nloc, unsigned& nx) {
    const unsigned G = gridDim.x * gridDim.y * gridDim.z;
    unsigned sum, cnt, mine, sp = 0u;
    for (;;) {
        sum = 0u; cnt = 0u; mine = 0u;
#pragma unroll
        for (unsigned j = 0; j < 16; ++j) { const unsigned c = xb_ld(&bar[XB_XCNT(j)]); sum += c; cnt += (c > 0u) ? 1u : 0u; mine = (j == x) ? c : mine; }
        if (sum == G) break;
        __builtin_amdgcn_s_sleep(1);
        if ((++sp & 255u) == 0u) { if (xb_ld(&bar[XB_TMO])) break; if (sp > XB_SPIN_CAP) { atomicAdd(&bar[XB_TMO], 1u); break; } }
    }
    nloc = mine > 0u ? mine : 1u; nx = cnt > 0u ? cnt : 1u;
}

__device__ __forceinline__ void xcd_barrier(const XcdBarrier& b) {
    asm volatile("s_waitcnt vmcnt(0)" ::: "memory");
    __syncthreads();
    if (b.w == 0 && pg8::fresh_lane() == 0) {
        unsigned* bar = b.bar;
        __builtin_amdgcn_s_waitcnt(0);
        unsigned nloc = b.st[0], nx = b.st[1];
        if (nloc == 0u) { xcd_barrier_complete(bar, b.x, nloc, nx); b.st[0] = nloc; b.st[1] = nx; }
        const unsigned old = xb_add(&bar[XB_XSUB(b.x)], 1u);
        const unsigned gen = old / nloc;
        if (old + 1u == (gen + 1u) * nloc) {
            __builtin_amdgcn_fence(__ATOMIC_RELEASE, "agent");
            asm volatile("s_waitcnt vmcnt(0)" ::: "memory");
            const unsigned og = xb_add(&bar[XB_TOP], 1u);
            const unsigned tg = og / nx;
            if (og + 1u == (tg + 1u) * nx) xb_add(&bar[XB_TOPGEN], 1u);
            else XB_SPIN(xb_ld(&bar[XB_TOPGEN]) == tg, bar);
            __builtin_amdgcn_fence(__ATOMIC_ACQUIRE, "agent");
            xb_add(&bar[XB_XGEN(b.x)], 1u);
            asm volatile("s_waitcnt vmcnt(0)" ::: "memory");
        } else {
            XB_SPIN(xb_ld(&bar[XB_XGEN(b.x)]) == gen, bar);
            __builtin_amdgcn_fence(__ATOMIC_ACQUIRE, "agent");
            asm volatile("s_waitcnt vmcnt(0)" ::: "memory");
        }
    }
    __syncthreads();
}


template <int K> __device__ __forceinline__ void xcd_local_barrier(const XcdBarrier& b) {
    asm volatile("s_waitcnt vmcnt(0)" ::: "memory");
    __syncthreads();
    if (b.w == 0 && pg8::fresh_lane() == 0) {
        unsigned* cnt = b.bar + 3456 + 64 * b.x;
        __builtin_amdgcn_s_waitcnt(0);
        (void)xb_add(cnt, 1u);
        XB_SPIN(xb_ld(cnt) < 32u * (unsigned)(K + 1), b.bar);
        __builtin_amdgcn_fence(__ATOMIC_ACQUIRE, "agent");
        asm volatile("s_waitcnt vmcnt(0)" ::: "memory");
    }
    __syncthreads();
}

constexpr int LDS_BYTES = 163840;
__global__ void __launch_bounds__(NTHR, 2) mk_fwd(Args a) {
    cg::grid_group grid = cg::this_grid();
    extern __shared__ __attribute__((aligned(16))) unsigned char lds_raw[];
    LAS unsigned char* lds = (LAS unsigned char*)lds_raw;
    const int tid = threadIdx.x, lane = tid & 63, wave = __builtin_amdgcn_readfirstlane(tid >> 6);
    const int G = gridDim.x, gw = blockIdx.x * NWAVES + wave, NGW = G * NWAVES;
    unsigned char* ws = a.ws;
    const pg8::bf16_t* XB = (const pg8::bf16_t*)((const unsigned char*)a.out + OUT_XB);
    const pg8::bf16_t* WIN = (const pg8::bf16_t*)(ws + WS_WIN);
    float* R1 = (float*)(ws + WS_R1);

    volatile LAS unsigned* MISC = (volatile LAS unsigned*)(lds + 163584);
    if (tid < 64) MISC[tid] = 0u;
    __syncthreads();
    const XcdBarrier bar = xcd_barrier_post((unsigned*)(ws + WS_BAR), MISC + 8, wave);
    grid.sync();
#define GSYNC() xcd_barrier(bar)
#define T0() (wave == 0 && pg8::fresh_lane() == 0)
#define XLOCAL() (__builtin_amdgcn_readfirstlane((int)MISC[11]) != 0)
    p0_prologue(a, lds, gw, NGW, wave, lane);
    if (T0()) __hip_atomic_store((unsigned*)(ws + WS_BAR + 18432) + blockIdx.x, bar.x + 1u, __ATOMIC_RELAXED, __HIP_MEMORY_SCOPE_AGENT);
    GSYNC();
    if (T0()) { bool ok = (gridDim.x == 256) && (MISC[8] == 32u);
        for (int j = 0; j < 32 && ok; ++j) ok = __hip_atomic_load((unsigned*)(ws + WS_BAR + 18432) + (blockIdx.x & 7) + 8 * j, __ATOMIC_RELAXED, __HIP_MEMORY_SCOPE_AGENT) == bar.x + 1u;
        if (!ok) __hip_atomic_store((unsigned*)(ws + WS_BAR + 20480), 1u, __ATOMIC_RELAXED, __HIP_MEMORY_SCOPE_AGENT); }
    dt_phase(a, lds, 0, wave, 0);
    {
        using SO = pg8::StaticOrder;
        const pg8::Gemm g1{WIN + (size_t)2048 * DM, XB, DM, M, DM}; SO S1; S1.init(DM, M, G, (int)blockIdx.x);
        const pg8::Gemm g2{XB, WIN, M, 2048, DM}; SO S2; S2.init(M, 2048, G, (int)blockIdx.x);
        const pg8::Gemm g3{XB, WIN + (size_t)3072 * DM, M, 3072, DM}; SO S3; S3.init(M, 3072, G, (int)blockIdx.x);
        pg8::Unit u2, u3; (void)S2.next(0, u2); (void)S3.next(0, u3);
        const char* a2 = (const char*)g2.A + (size_t)u2.pm * 512 * DM; const char* b2 = (const char*)g2.Bt + (size_t)u2.pn * 512 * DM;
        const char* a3 = (const char*)g3.A + (size_t)u3.pm * 512 * DM; const char* b3 = (const char*)g3.Bt + (size_t)u3.pn * 512 * DM;
        const ep::EpiVt E1{(pg8::bf16_t*)(ws + WS_V), R1};
        const ep::EpiQKV E2{(pg8::bf16_t*)(ws + WS_Q), (pg8::bf16_t*)(ws + WS_K), (pg8::bf16_t*)(ws + WS_V), R1, a.in[I_GQ], a.in[I_GK], (float*)(ws + WS_KMEAN)};
        const ep::EpiAct<0> E3{(pg8::bf16_t*)(ws + WS_XBC), 3072, R1, 0, 0};
        pg8::gemm_phase<ep::EpiVt, SO, true, true, false, true>(lds, g1, S1, E1, wave, a2, b2);
        pg8::gemm_phase<ep::EpiQKV, SO, true, true, true, true>(lds, g2, S2, E2, wave, a3, b3);
        pg8::gemm_phase<ep::EpiAct<0>, SO, true, true, true, false>(lds, g3, S3, E3, wave);
    }
    GSYNC();
    if (T0()) MISC[11] = __hip_atomic_load((unsigned*)(ws + WS_BAR + 20480), __ATOMIC_RELAXED, __HIP_MEMORY_SCOPE_AGENT) == 0u ? 1u : 0u;
    __syncthreads();
    attn_mfma(a, lds, 0, wave, 0, (bf16*)(ws + WS_Q), XLOCAL() && gridDim.x == 256, (unsigned*)(ws + WS_BAR) + 5632 + 64 * (blockIdx.x & 7));
    ssd_s1(a, lds, 0, wave, 0);
    GSYNC();
    ssd_s2(a, wave * 64 + pg8::fresh_lane());
    { pg8::Gemm g{XB, WIN + (size_t)6144 * DM, M, 2048, DM}; pg8::StaticOrder S; S.init(M, 2048, G, (int)blockIdx.x);
      ep::EpiAct<1> E{(pg8::bf16_t*)(ws + WS_Z), 2048, R1, 0, 0};
      pg8::gemm_phase<ep::EpiAct<1>, pg8::StaticOrder, true, true>(lds, g, S, E, wave); }
    GSYNC();
    ssd_s3(a, lds, 0, wave, 0);
    GSYNC();
    {   using SO = pg8::StaticOrder; SO S; S.init(M, DM, G, (int)blockIdx.x);
        const pg8::Gemm g1{XB, WIN + (size_t)8192 * DM, M, DM, DM}, g2{XB, WIN + (size_t)9216 * DM, M, DM, DM}, g3{(const pg8::bf16_t*)(ws + WS_Q), (const pg8::bf16_t*)(ws + WS_WOA), M, DM, DM};
        pg8::Unit u0; (void)S.next(0, u0);
        const ep::EpiAct<2> E1{(pg8::bf16_t*)(ws + WS_GA), 1024, R1, 0, 0}, E2{(pg8::bf16_t*)(ws + WS_GB), 1024, R1, 0, 0}; const ep::EpiGate1 E3{(pg8::bf16_t*)(ws + WS_GA)};
        pg8::gemm_phase<ep::EpiAct<2>, SO, true, true, false, true>(lds, g1, S, E1, wave, (const char*)g2.A + (size_t)u0.pm * 512 * DM, (const char*)g2.Bt + (size_t)u0.pn * 512 * DM);
        pg8::gemm_phase<ep::EpiAct<2>, SO, true, true, true, true>(lds, g2, S, E2, wave, (const char*)g3.A + (size_t)u0.pm * 512 * DM, (const char*)g3.Bt + (size_t)u0.pn * 512 * DM);
        pg8::gemm_phase<ep::EpiGate1, SO, true, true, true, false>(lds, g3, S, E3, wave);
    }
    { pg8::Gemm g{(const pg8::bf16_t*)(ws + WS_Z), (const pg8::bf16_t*)(ws + WS_WOS), M, DM, SSM_IN}; pg8::StaticOrder S; S.init(M, DM, G, (int)blockIdx.x);
      ep::EpiGate2 E{(pg8::bf16_t*)(ws + WS_GA), (const pg8::bf16_t*)(ws + WS_GB)};
      pg8::gemm_phase<ep::EpiGate2, pg8::StaticOrder, true, true>(lds, g, S, E, wave); }
    if (XLOCAL()) xcd_local_barrier<0>(bar); else GSYNC();
    { pg8::Gemm g{(const pg8::bf16_t*)(ws + WS_GA), (const pg8::bf16_t*)(ws + WS_WOUT), M, DM, DM}; pg8::StaticOrder S; S.init(M, DM, G, (int)blockIdx.x);
      ep::EpiRes<false> E{a.in[I_X], (pg8::bf16_t*)(ws + WS_X1B), (float*)(ws + WS_R2P)};
      pg8::gemm_phase<ep::EpiRes<false>, pg8::StaticOrder, true, true>(lds, g, S, E, wave); }
    GSYNC();
    { pg8::Gemm g{(const pg8::bf16_t*)(ws + WS_X1B), (const pg8::bf16_t*)(ws + WS_WGU), M, 2 * DFF, DM}; pg8::StaticOrder S; S.init(M, 2 * DFF, G, (int)blockIdx.x);
      ep::EpiSwiGLU E{(pg8::bf16_t*)(ws + WS_ACT), (const float*)(ws + WS_R2P)};
      pg8::gemm_phase<ep::EpiSwiGLU, pg8::StaticOrder, true, true>(lds, g, S, E, wave); }
    { int kple = PLE; asm volatile("" : "+s"(kple));
      pg8::Gemm g{(const pg8::bf16_t*)(ws + WS_PB), (const pg8::bf16_t*)(ws + WS_WPP), M, DM, kple}; pg8::StaticOrder S;
      if (G == 256) S.init(M, DM, 128, (int)blockIdx.x >= 128 ? (int)blockIdx.x - 128 : 4096); else S.init(M, DM, G, (int)blockIdx.x);
      ep::EpiAct<0> E{(pg8::bf16_t*)(ws + WS_PP), 1024, nullptr, 0, 0};
      pg8::gemm_phase<ep::EpiAct<0>, pg8::StaticOrder, true, true>(lds, g, S, E, wave); }
    if (XLOCAL()) xcd_local_barrier<1>(bar); else GSYNC();
    { pg8::Gemm g{(const pg8::bf16_t*)(ws + WS_ACT), (const pg8::bf16_t*)(ws + WS_WDN), M, DM, DFF}; pg8::StaticOrder S; S.init(M, DM, G, (int)blockIdx.x);
      ep::EpiRes<true> E{(const void*)(ws + WS_X1B), (pg8::bf16_t*)(ws + WS_X2B), (float*)(ws + WS_R3P)};
      pg8::gemm_phase<ep::EpiRes<true>, pg8::StaticOrder, true, true>(lds, g, S, E, wave); }
    if (XLOCAL()) xcd_local_barrier<2>(bar); else GSYNC();
    { pg8::Gemm g{(const pg8::bf16_t*)(ws + WS_X2B), (const pg8::bf16_t*)(ws + WS_WPG), M, DM, DM}; pg8::StaticOrder S; S.init(M, DM, G, (int)blockIdx.x);
      ep::EpiPle E{a.out, (const pg8::bf16_t*)(ws + WS_X2B), (const pg8::bf16_t*)(ws + WS_PP), (const float*)(ws + WS_R3P)};
      pg8::gemm_phase<ep::EpiPle, pg8::StaticOrder, true, true>(lds, g, S, E, wave); }
}

extern "C" void kernel_launch(void* const* d_in, const int* in_sizes, int n_in, void* d_out, int out_size, void* d_ws, size_t ws_size, hipStream_t stream) {
    static int grid = 0;
    if (grid == 0) {
        if (n_in != 21 || out_size != M * DM || ws_size < WS_END) { fprintf(stderr, "kernel_launch: unexpected problem (n_in %d out %d ws %zu); nothing launched\n", n_in, out_size, ws_size); grid = -1; return; }
        int dev = 0, cus = 0, per_cu = 0;
        if (hipGetDevice(&dev) != hipSuccess || hipDeviceGetAttribute(&cus, hipDeviceAttributeMultiprocessorCount, dev) != hipSuccess) { grid = -1; return; }
        if (hipFuncSetAttribute((const void*)mk_fwd, hipFuncAttributeMaxDynamicSharedMemorySize, LDS_BYTES) != hipSuccess) { fprintf(stderr, "kernel_launch: hipFuncSetAttribute failed\n"); grid = -1; return; }
        if (hipOccupancyMaxActiveBlocksPerMultiprocessor(&per_cu, (const void*)mk_fwd, NTHR, LDS_BYTES) != hipSuccess || per_cu < 1) { fprintf(stderr, "kernel_launch: occupancy query says %d blocks/CU\n", per_cu); grid = -1; return; }
        grid = cus < 256 ? cus : 256;
        (void)hipGetLastError();
    }
    if (grid < 0) return;
    if (hipMemsetAsync((char*)d_ws + WS_BAR, 0, BAR_BYTES, stream) != hipSuccess) { fprintf(stderr, "kernel_launch: memset failed\n"); return; }
    Args a{};
    for (int i = 0; i < 21; ++i) a.in[i] = (const float*)d_in[i];
    a.out = (float*)d_out; a.ws = (unsigned char*)d_ws;
    void* args[] = {&a};
    hipError_t e = hipLaunchCooperativeKernel((const void*)mk_fwd, dim3(grid), dim3(NTHR), args, LDS_BYTES, stream);
    if (e != hipSuccess) fprintf(stderr, "cooperative launch failed: %s (grid %d)\n", hipGetErrorString(e), grid);
}
```
